# Optimizing an MI355X kernel written in HIP

```python
import jax, jax.numpy as jnp
from jax import lax
import numpy as np

D_MODEL = 1024
BATCH = 8
SEQ = 2048
DEPTH = 2

GRID_W = 64
CTX_LEN = 256
EPS = 1e-6
N_MIXERS = 2
NEG_INF = -1e30

A_HEADS = 16
A_KV_HEADS = 2
A_HEAD_DIM = 64
A_GROUP = A_HEADS // A_KV_HEADS
A_WIDTH = A_HEADS * A_HEAD_DIM
A_KV_WIDTH = A_KV_HEADS * A_HEAD_DIM
A_SPLITS = (A_WIDTH, A_WIDTH + A_KV_WIDTH, A_WIDTH + 2 * A_KV_WIDTH)
A_IN_WIDTH = 2 * A_WIDTH + 2 * A_KV_WIDTH
WINDOW = 128
BLOCK = 128
ROPE_BASE = 10000.0
ROPE_FREQS = A_HEAD_DIM // 4

B_HEADS = 4
B_K_WIDTH = D_MODEL // 2
B_V_WIDTH = D_MODEL
B_KEY_DIM = B_K_WIDTH // B_HEADS
B_VAL_DIM = B_V_WIDTH // B_HEADS
B_SPLITS = (B_K_WIDTH, 2 * B_K_WIDTH, 2 * B_K_WIDTH + B_V_WIDTH)
B_IN_WIDTH = 2 * B_K_WIDTH + 2 * B_V_WIDTH
GATE_RANK = 16
GATE_TEMP = 16.0
CHUNK = 64

kernel_name = 'hybrid_swa_sink_gla_prefix_dit'


def rmsnorm(x, g):
    xf = x.astype(jnp.float32)
    y = xf * lax.rsqrt(jnp.mean(xf * xf, axis=-1, keepdims=True) + EPS)
    return (y * g.astype(jnp.float32)).astype(x.dtype)


def modulation(cvec, w_ada, b_ada, n):
    m = jax.nn.silu(cvec) @ w_ada[:, :n * D_MODEL] + b_ada[:n * D_MODEL]
    return jnp.split(m, n, axis=-1)


def modulate(h, shift, scale):
    return h * (1 + scale[..., None, :]) + shift[..., None, :]


def heads(t, n_heads):
    return t.reshape(t.shape[0], t.shape[1], n_heads, -1)


def axial_rope_tables(n_tokens):
    rows_n = n_tokens // GRID_W
    row = jnp.repeat(jnp.arange(rows_n, dtype=jnp.float32), GRID_W)
    col = jnp.tile(jnp.arange(GRID_W, dtype=jnp.float32), rows_n)
    inv_freq = ROPE_BASE ** (-jnp.arange(ROPE_FREQS, dtype=jnp.float32) / ROPE_FREQS)
    ang = jnp.stack([row[:, None] * inv_freq, col[:, None] * inv_freq], axis=1)
    return jnp.cos(ang), jnp.sin(ang)


def apply_axial_rope(x, cos, sin):
    b_, s_, h_, _ = x.shape
    xr = x.reshape(b_, s_, h_, 2, 2, ROPE_FREQS)
    x1, x2 = xr[..., 0, :], xr[..., 1, :]
    c = cos[None, :, None]
    s = sin[None, :, None]
    y = jnp.stack([x1 * c - x2 * s, x1 * s + x2 * c], axis=-2)
    return y.reshape(x.shape).astype(x.dtype)


def softmax_with_sink(parts, sink_logit):
    logits = jnp.concatenate(parts + [sink_logit], axis=-1)
    return jax.nn.softmax(logits, axis=-1)[..., :-1]


def attn_layer(x, xc, c, c_ctx, norm_g, w_ada, b_ada, w_in, sink, w_out, last):
    f32 = jnp.float32
    b_, s_, _ = x.shape
    n_ctx = xc.shape[1]
    nb = s_ // BLOCK
    qscale = A_HEAD_DIM ** -0.5
    sink_kg = sink.astype(f32).reshape(A_KV_HEADS, A_GROUP)

    shift, scl, gate = modulation(c, w_ada, b_ada, 3)
    h = modulate(rmsnorm(x, norm_g), shift, scl)
    q, k, v, g = jnp.split(h @ w_in, A_SPLITS, axis=-1)
    cos, sin = axial_rope_tables(s_)
    q = apply_axial_rope(heads(q, A_HEADS), cos, sin)
    k = apply_axial_rope(heads(k, A_KV_HEADS), cos, sin)
    v = heads(v, A_KV_HEADS)

    if last:
        shift_c, scl_c = modulation(c_ctx, w_ada, b_ada, 2)
        hc = modulate(rmsnorm(xc, norm_g), shift_c, scl_c)
        kc, vc = jnp.split(hc @ w_in[:, A_WIDTH:A_WIDTH + 2 * A_KV_WIDTH], 2, axis=-1)
    else:
        shift_c, scl_c, gate_c = modulation(c_ctx, w_ada, b_ada, 3)
        hc = modulate(rmsnorm(xc, norm_g), shift_c, scl_c)
        qc, kc, vc, gc = jnp.split(hc @ w_in, A_SPLITS, axis=-1)
    kc = heads(kc, A_KV_HEADS)
    vc = heads(vc, A_KV_HEADS)

    qb = q.reshape(b_, nb, BLOCK, A_KV_HEADS, A_GROUP, A_HEAD_DIM) * qscale
    pad = ((0, 0), (BLOCK, BLOCK), (0, 0), (0, 0))
    kp = jnp.pad(k, pad).reshape(b_, nb + 2, BLOCK, A_KV_HEADS, A_HEAD_DIM)
    vp = jnp.pad(v, pad).reshape(b_, nb + 2, BLOCK, A_KV_HEADS, A_HEAD_DIM)
    kwin = jnp.concatenate([kp[:, :-2], kp[:, 1:-1], kp[:, 2:]], axis=2)
    vwin = jnp.concatenate([vp[:, :-2], vp[:, 1:-1], vp[:, 2:]], axis=2)
    s_loc = jnp.einsum('bnqkgd,bnskd->bnkgqs', qb, kwin).astype(f32)
    s_ctx = jnp.einsum('bnqkgd,bckd->bnkgqc', qb, kc).astype(f32)
    qpos = jnp.arange(s_).reshape(nb, BLOCK)
    kpos = (jnp.arange(nb) * BLOCK - BLOCK)[:, None] + jnp.arange(3 * BLOCK)[None, :]
    kk = kpos[:, None, :]
    valid = (kk >= 0) & (kk < s_) & (jnp.abs(kk - qpos[:, :, None]) <= WINDOW)
    s_loc = jnp.where(valid[None, :, None, None], s_loc, NEG_INF)
    sink_b = jnp.broadcast_to(sink_kg[None, None, :, :, None, None], s_loc.shape[:-1] + (1,))
    p = softmax_with_sink([s_loc, s_ctx], sink_b)
    p_loc = p[..., :3 * BLOCK].astype(v.dtype)
    p_ctx = p[..., 3 * BLOCK:].astype(v.dtype)
    o = (jnp.einsum('bnkgqs,bnskd->bnqkgd', p_loc, vwin)
         + jnp.einsum('bnkgqc,bckd->bnqkgd', p_ctx, vc))
    o = o.reshape(b_, s_, A_WIDTH) * jax.nn.silu(g)
    x_new = x + gate[:, None, :] * (o @ w_out)

    if last:
        return x_new, None
    qcb = qc.reshape(b_, n_ctx, A_KV_HEADS, A_GROUP, A_HEAD_DIM) * qscale
    sc = jnp.einsum('bqkgd,bckd->bkgqc', qcb, kc).astype(f32)
    sink_c = jnp.broadcast_to(sink_kg[None, :, :, None, None], sc.shape[:-1] + (1,))
    pc = softmax_with_sink([sc], sink_c).astype(vc.dtype)
    oc = jnp.einsum('bkgqc,bckd->bqkgd', pc, vc).reshape(b_, n_ctx, A_WIDTH) * jax.nn.silu(gc)
    xc_new = xc + gate_c[..., None, :] * (oc @ w_out)
    return x_new, xc_new


def log_decay(h, wa1, wa2, ba):
    z = (h @ wa1) @ wa2 + ba
    return heads(jax.nn.log_sigmoid(z.astype(jnp.float32)) / GATE_TEMP, B_HEADS)


def gla_chunked(q, k, v, log_a, s0):
    b_, t_, h_, _ = q.shape
    nc = t_ // CHUNK
    rs = lambda t: t.reshape(b_, nc, CHUNK, h_, t.shape[-1]).astype(jnp.float32)
    qc, kc, vc, la = rs(q), rs(k), rs(v), rs(log_a)
    cum = jnp.cumsum(la, axis=2)
    total = cum[:, :, -1:]
    q_dec = qc * jnp.exp(cum)
    k_inv = kc * jnp.exp(-cum)
    k_end = kc * jnp.exp(total - cum)
    causal = jnp.tril(jnp.ones((CHUNK, CHUNK), dtype=bool))
    a = jnp.einsum('bnthd,bnshd->bnhts', q_dec, k_inv)
    a = jnp.where(causal, a, 0.0)
    o_intra = jnp.einsum('bnhts,bnshe->bnthe', a, vc)
    kv_chunk = jnp.einsum('bnshd,bnshe->bnhde', k_end, vc)
    decay_chunk = jnp.exp(total[:, :, 0])

    def step(s, inp):
        qd, kv, dec = inp
        o_inter = jnp.einsum('bthd,bhde->bthe', qd, s)
        return s * dec[..., None] + kv, o_inter

    s_final, o_inter = lax.scan(step, s0.astype(jnp.float32),
                                (jnp.swapaxes(q_dec, 0, 1), jnp.swapaxes(kv_chunk, 0, 1),
                                 jnp.swapaxes(decay_chunk, 0, 1)))
    o = o_intra + jnp.swapaxes(o_inter, 0, 1)
    return o.reshape(b_, t_, h_, v.shape[-1]), s_final


def gla_final_state(k, v, log_a):
    cum = jnp.cumsum(log_a.astype(jnp.float32), axis=1)
    kd = k.astype(jnp.float32) * jnp.exp(cum[:, -1:] - cum)
    return jnp.einsum('bthd,bthe->bhde', kd, v.astype(jnp.float32))


def gla_output(o, g, head_norm_g, w_out):
    of = o * lax.rsqrt(jnp.mean(o * o, axis=-1, keepdims=True) + EPS)
    of = of.reshape(o.shape[0], o.shape[1], B_V_WIDTH) * head_norm_g.astype(jnp.float32)
    return (of.astype(g.dtype) * jax.nn.silu(g)) @ w_out


def gla_layer(x, xc, c, c_ctx, norm_g, w_ada, b_ada, w_in, wa1_f, wa2_f, ba_f,
              wa1_b, wa2_b, ba_b, head_norm_g, w_out, last):
    flip = lambda t: jnp.flip(t, axis=1)
    kscale = B_KEY_DIM ** -0.5
    b_ = x.shape[0]

    shift, scl, gate = modulation(c, w_ada, b_ada, 3)
    h = modulate(rmsnorm(x, norm_g), shift, scl)
    q, k, v, g = jnp.split(h @ w_in, B_SPLITS, axis=-1)
    q = heads(q, B_HEADS) * kscale
    k = heads(k, B_HEADS)
    v = heads(v, B_HEADS)
    la_f = log_decay(h, wa1_f, wa2_f, ba_f)
    la_b = log_decay(h, wa1_b, wa2_b, ba_b)

    if last:
        shift_c, scl_c = modulation(c_ctx, w_ada, b_ada, 2)
        hc = modulate(rmsnorm(xc, norm_g), shift_c, scl_c)
        kc, vc = jnp.split(hc @ w_in[:, B_K_WIDTH:2 * B_K_WIDTH + B_V_WIDTH], [B_K_WIDTH], axis=-1)
        kc, vc = heads(kc, B_HEADS), heads(vc, B_HEADS)
        s_f = gla_final_state(kc, vc, log_decay(hc, wa1_f, wa2_f, ba_f))
        s_b = gla_final_state(flip(kc), flip(vc), flip(log_decay(hc, wa1_b, wa2_b, ba_b)))
        xc_new = None
    else:
        shift_c, scl_c, gate_c = modulation(c_ctx, w_ada, b_ada, 3)
        hc = modulate(rmsnorm(xc, norm_g), shift_c, scl_c)
        qc, kc, vc, gc = jnp.split(hc @ w_in, B_SPLITS, axis=-1)
        qc = heads(qc, B_HEADS) * kscale
        kc, vc = heads(kc, B_HEADS), heads(vc, B_HEADS)
        zeros = jnp.zeros((b_, B_HEADS, B_KEY_DIM, B_VAL_DIM), jnp.float32)
        oc_f, s_f = gla_chunked(qc, kc, vc, log_decay(hc, wa1_f, wa2_f, ba_f), zeros)
        oc_b, s_b = gla_chunked(flip(qc), flip(kc), flip(vc),
                                flip(log_decay(hc, wa1_b, wa2_b, ba_b)), zeros)
        oc = gla_output(oc_f + flip(oc_b), gc, head_norm_g, w_out)
        xc_new = xc + gate_c[..., None, :] * oc

    o_f, _ = gla_chunked(q, k, v, la_f, s_f)
    o_b, _ = gla_chunked(flip(q), flip(k), flip(v), flip(la_b), s_b)
    o = gla_output(o_f + flip(o_b), g, head_norm_g, w_out)
    x_new = x + gate[:, None, :] * o
    return x_new, xc_new


def setup_inputs(seed: int = 0) -> dict:
    key = jax.random.key(seed)
    ks = iter(jax.random.split(key, 32))
    D = D_MODEL
    nrm = lambda shape, s: jax.random.normal(next(ks), shape, jnp.float32) * s
    return {
        'x': nrm((BATCH, SEQ, D), 1.0),
        'c': nrm((BATCH, D), 1.0),
        'ctx': nrm((BATCH, CTX_LEN, D), 1.0),
        'c_ctx': nrm((D,), 1.0),
        'l0_norm_g': 1.0 + nrm((D,), 0.02),
        'l0_w_ada': nrm((D, 3 * D), D ** -0.5),
        'l0_b_ada': nrm((3 * D,), 0.02),
        'l0_w_in': nrm((D, A_IN_WIDTH), D ** -0.5),
        'l0_sink': nrm((A_HEADS,), 0.5),
        'l0_w_out': nrm((A_WIDTH, D), A_WIDTH ** -0.5),
        'l1_norm_g': 1.0 + nrm((D,), 0.02),
        'l1_w_ada': nrm((D, 3 * D), D ** -0.5),
        'l1_b_ada': nrm((3 * D,), 0.02),
        'l1_w_in': nrm((D, B_IN_WIDTH), D ** -0.5),
        'l1_wa1_f': nrm((D, GATE_RANK), D ** -0.5),
        'l1_wa2_f': nrm((GATE_RANK, B_K_WIDTH), GATE_RANK ** -0.5),
        'l1_ba_f': nrm((B_K_WIDTH,), 0.1),
        'l1_wa1_b': nrm((D, GATE_RANK), D ** -0.5),
        'l1_wa2_b': nrm((GATE_RANK, B_K_WIDTH), GATE_RANK ** -0.5),
        'l1_ba_b': nrm((B_K_WIDTH,), 0.1),
        'l1_head_norm_g': 1.0 + nrm((B_V_WIDTH,), 0.02),
        'l1_w_out': nrm((B_V_WIDTH, D), B_V_WIDTH ** -0.5),
        'final_norm_g': 1.0 + nrm((D,), 0.02),
    }


def reference(x, c, ctx, c_ctx,
              l0_norm_g, l0_w_ada, l0_b_ada, l0_w_in, l0_sink, l0_w_out,
              l1_norm_g, l1_w_ada, l1_b_ada, l1_w_in, l1_wa1_f, l1_wa2_f, l1_ba_f,
              l1_wa1_b, l1_wa2_b, l1_ba_b, l1_head_norm_g, l1_w_out,
              final_norm_g):
    mixers = (attn_layer, gla_layer)
    layer_params = (
        (l0_norm_g, l0_w_ada, l0_b_ada, l0_w_in, l0_sink, l0_w_out),
        (l1_norm_g, l1_w_ada, l1_b_ada, l1_w_in, l1_wa1_f, l1_wa2_f, l1_ba_f,
         l1_wa1_b, l1_wa2_b, l1_ba_b, l1_head_norm_g, l1_w_out),
    )
    xc = ctx
    for i in range(DEPTH):
        fn = mixers[i % N_MIXERS]
        x, xc = fn(x, xc, c, c_ctx, *layer_params[i], last=(i == DEPTH - 1))
    return rmsnorm(x, final_norm_g)
```

```cpp
#include <hip/hip_runtime.h>
#include <hip/hip_cooperative_groups.h>
#include <cstdio>
#include <cstdint>
namespace cg = cooperative_groups;

#define LAS __attribute__((address_space(3)))
#define GAS __attribute__((address_space(1)))
typedef unsigned short bf16_t;
typedef short bf16x8 __attribute__((ext_vector_type(8)));
typedef short s16x4 __attribute__((ext_vector_type(4)));
typedef float f32x4 __attribute__((ext_vector_type(4)));
typedef unsigned u32x4 __attribute__((ext_vector_type(4)));
typedef unsigned u32x2 __attribute__((ext_vector_type(2)));

#ifndef MK_N_LAUNCHES
#define MK_N_LAUNCHES 1
#endif

constexpr int D = 1024, NBATCH = 8, SEQ = 2048, CTXL = 256;
constexpr int ML = NBATCH * SEQ;
constexpr int MC = NBATCH * CTXL;
constexpr int MT = ML + MC;
constexpr int N0 = 2304;
constexpr int N1 = 3072;
constexpr int N1P = 3328;
constexpr float EPS = 1e-6f;
constexpr int NPHASE = 12;

constexpr size_t WS_WT0 = 0;
constexpr size_t WS_WO0 = WS_WT0 + (size_t)N0 * D * 2;
constexpr size_t WS_WT1 = WS_WO0 + (size_t)D * D * 2;
constexpr size_t WS_WO1 = WS_WT1 + (size_t)N1P * D * 2;
constexpr size_t WS_MOD1 = WS_WO1 + (size_t)D * D * 2;
constexpr size_t WS_ROPE = WS_MOD1 + 9 * 3072 * 4;
constexpr size_t WS_R = WS_ROPE + 2 * 64 * 16 * 4;
constexpr size_t WS_DEC = WS_R + (size_t)MT * 32 * 4;
constexpr size_t WS_X1 = WS_DEC + (size_t)2 * 8 * 4 * 36 * 128 * 4;
constexpr size_t WS_A = WS_X1 + (size_t)MT * D * 2;
constexpr size_t WS_B = WS_A + (size_t)MT * N1 * 2;
constexpr size_t WS_CTL = WS_B + (size_t)MT * D * 2;
constexpr size_t CTL_BYTES = 32768 + (size_t)ML * 8 + 9 * 3072 * 4 + (size_t)MT * 8;
constexpr size_t WS_SS = WS_CTL + 32768;
constexpr size_t WS_MOD0 = WS_SS + (size_t)ML * 8;
constexpr size_t WS_SS4 = WS_MOD0 + 9 * 3072 * 4;
constexpr size_t WS_END = WS_CTL + CTL_BYTES;
static_assert(WS_END <= 268435456, "d_ws map");

constexpr int LDS_BYTES = 147456;
constexpr int LDS_MISC_OFF = LDS_BYTES - 64;

typedef __bf16 bf16x2_t __attribute__((ext_vector_type(2)));
typedef float f32x2_t __attribute__((ext_vector_type(2)));
__device__ __forceinline__ unsigned cvt_pk_bf16(float lo, float hi) { f32x2_t v = {lo, hi}; bf16x2_t r = __builtin_convertvector(v, bf16x2_t); return __builtin_bit_cast(unsigned, r); }
__device__ __forceinline__ float bf2f(bf16_t u) { return __builtin_bit_cast(float, (unsigned)u << 16); }
__device__ __forceinline__ float bflo(unsigned u) { return __builtin_bit_cast(float, u << 16); }
__device__ __forceinline__ float bfhi(unsigned u) { return __builtin_bit_cast(float, u & 0xffff0000u); }
__device__ __forceinline__ bf16_t f2bf(float f) { return (bf16_t)(cvt_pk_bf16(f, 0.f) & 0xffffu); }
__device__ __forceinline__ float silu_f(float x) { return x * __builtin_amdgcn_rcpf(1.f + __expf(-x)); }
#define LDS_BARRIER() do { asm volatile("s_waitcnt lgkmcnt(0)" ::: "memory"); __builtin_amdgcn_s_barrier(); asm volatile("" ::: "memory"); } while (0)
__device__ __forceinline__ s16x4 lds_tr4(const LAS bf16_t* p) { return __builtin_amdgcn_ds_read_tr16_b64_v4i16((LAS s16x4*)p); }
__device__ __forceinline__ float wave_sum(float v) {
#pragma unroll
    for (int o = 1; o < 64; o <<= 1) v += __shfl_xor(v, o);
    return v;
}

namespace pg8 {
constexpr int BM = 256, BK = 64, HALF = 128, HTB = HALF * BK * 2, STAGE_BYTES = 8 * HTB, NXCD = 8, WGM = 8;
__host__ __device__ __forceinline__ int lds_byte(int r, int c) { const int st = (r >> 4) * 2 + (c >> 5), rr = r & 15, cc = c & 31, ob = rr * 64 + cc * 2; return st * 1024 + (ob ^ (((ob >> 9) & 1) << 5)); }
__host__ __device__ __forceinline__ void stage_rc(int b, int& R, int& C) { const int st = b / 1024, sb = b % 1024, swz = sb ^ (((sb >> 9) & 1) << 5); R = (st >> 1) * 16 + swz / 64; C = (st & 1) * 32 + (swz % 64) / 2; }
__host__ __device__ __forceinline__ int perm32(int rho) { const int n = rho >> 4, i = rho & 15; return 8 * (i >> 2) + 4 * n + (i & 3); }

struct Unit { int pm, pn; };
struct Gemm { const bf16_t* A; const bf16_t* Bt; int M, N, K; };

struct Sched {
    int nM, nN, nwg, G, c, nx;
    __device__ void init(int M, int N, int G_, int c_, int nx_) { nM = M / BM; nN = N / BM; nwg = nM * nN; G = G_; c = c_; nx = nx_; }
    __device__ bool next(int i, Unit& u) const {
        const long L = (long)i * G + c; if (L >= nwg + nx) return false;
        if (L >= nwg) { const int e = (int)L - nwg; u.pm = 64 + e / 7; const int j = e % 7; u.pn = j < 6 ? 2 + j : 12; return true; }
        int wgid = (int)L; { const int q = nwg / NXCD, r = nwg % NXCD, xcd = wgid % NXCD, off = wgid / NXCD; wgid = (xcd < r ? xcd * (q + 1) : r * (q + 1) + (xcd - r) * q) + off; }
        const int nig = WGM * nN, gid = wgid / nig, fm = gid * WGM, gsz = (nM - fm) < WGM ? (nM - fm) : WGM;
        u.pm = fm + ((wgid % nig) % gsz); u.pn = (wgid % nig) / gsz; return true;
    }
    __device__ __forceinline__ void a_ready(const Unit&) const {}
    __device__ __forceinline__ void done(const Unit&) const {}
};


struct EpiQKVG0 {
    static constexpr bool PERM = true, AFTER_DRAIN = false, XCHG = false;
    bf16_t* O; const float* cosT; const float* sinT;
    __device__ __forceinline__ void operator()(const f32x4 (&acc)[2][2][4][2], const Unit& u, int wr, int wc, int fr, int fq) const {
        const int pn = u.pn; const bool latent = u.pm < 64;
        const float sc = (pn < 4) ? 0.125f * 1.4426950408889634f : 1.f;
        const bool rope0 = latent && pn <= 4, rope1 = latent && pn < 4;
#pragma unroll
        for (int ai = 0; ai < 2; ++ai)
#pragma unroll
            for (int mp = 0; mp < 2; ++mp) {
                f32x4 tc[2][2], ts[2][2];
                if (rope0) {
#pragma unroll
                    for (int mm = 0; mm < 2; ++mm) {
                        const int tok = (u.pm * BM + ai * HALF + wr * 64 + (2 * mp + mm) * 16 + fr) & (SEQ - 1);
                        const int to = ((wc & 1) ? (tok & 63) : (tok >> 6)) * 16 + 8 * (fq & 1);
                        tc[mm][0] = *(const f32x4*)(cosT + to); tc[mm][1] = *(const f32x4*)(cosT + to + 4); ts[mm][0] = *(const f32x4*)(sinT + to); ts[mm][1] = *(const f32x4*)(sinT + to + 4);
                    }
                }
#pragma unroll
                for (int mm = 0; mm < 2; ++mm) {
                    const int m = 2 * mp + mm;
                    const int row = u.pm * BM + ai * HALF + wr * 64 + m * 16 + fr;
#pragma unroll
                    for (int bj = 0; bj < 2; ++bj) {
                        const int col = pn * BM + bj * HALF + wc * 32 + 8 * fq;
                        f32x4 v0 = acc[ai][bj][m][0], v1 = acc[ai][bj][m][1];
                        if (bj == 0 ? rope0 : rope1) {
                            f32x4 p0, p1;
#pragma unroll
                            for (int i = 0; i < 4; ++i) { p0[i] = __shfl_xor(v0[i], 32); p1[i] = __shfl_xor(v1[i], 32); }
                            if (fq < 2) { v0 = v0 * tc[mm][0] - p0 * ts[mm][0]; v1 = v1 * tc[mm][1] - p1 * ts[mm][1]; }
                            else        { v0 = p0 * ts[mm][0] + v0 * tc[mm][0]; v1 = p1 * ts[mm][1] + v1 * tc[mm][1]; }
                        }
                        v0 = v0 * sc; v1 = v1 * sc;
                        u32x4 w; w.x = cvt_pk_bf16(v0[0], v0[1]); w.y = cvt_pk_bf16(v0[2], v0[3]); w.z = cvt_pk_bf16(v1[0], v1[1]); w.w = cvt_pk_bf16(v1[2], v1[3]);
                        *(u32x4*)(O + (size_t)row * N0 + col) = w;
                    }
                }
            }
    }
};

struct EpiRes0 {
    static constexpr bool PERM = true, AFTER_DRAIN = false, XCHG = false;
    const float* res_lat; const float* res_ctx; const float* mod; bf16_t* out;
    __device__ __forceinline__ void operator()(const f32x4 (&acc)[2][2][4][2], const Unit& u, int wr, int wc, int fr, int fq) const {
#pragma unroll
        for (int ai = 0; ai < 2; ++ai)
#pragma unroll
            for (int m = 0; m < 4; ++m) {
                const int row = u.pm * BM + ai * HALF + wr * 64 + m * 16 + fr;
                const int v = row < ML ? (row >> 11) : 8;
                const float* rr = row < ML ? res_lat + (size_t)row * D : res_ctx + (size_t)(row - ML) * D;
                const float* gg = mod + v * 3072 + 2048;
                bf16_t* oo = out + (size_t)row * D;
#pragma unroll
                for (int bj = 0; bj < 2; ++bj) {
                    const int col = u.pn * BM + bj * HALF + wc * 32 + 8 * fq;
                    const f32x4 r0 = *(const f32x4*)(rr + col), r1 = *(const f32x4*)(rr + col + 4), g0 = *(const f32x4*)(gg + col), g1 = *(const f32x4*)(gg + col + 4);
                    const f32x4 v0 = r0 + g0 * acc[ai][bj][m][0], v1 = r1 + g1 * acc[ai][bj][m][1];
                    u32x4 w; w.x = cvt_pk_bf16(v0[0], v0[1]); w.y = cvt_pk_bf16(v0[2], v0[3]); w.z = cvt_pk_bf16(v1[0], v1[1]); w.w = cvt_pk_bf16(v1[2], v1[3]);
                    *(u32x4*)(oo + col) = w;
                }
            }
    }
};
struct EpiRes1 {
    static constexpr bool PERM = true, AFTER_DRAIN = false, XCHG = false;
    const bf16_t* res; const float* mod; bf16_t* out;
    __device__ __forceinline__ void operator()(const f32x4 (&acc)[2][2][4][2], const Unit& u, int wr, int wc, int fr, int fq) const {
#pragma unroll
        for (int ai = 0; ai < 2; ++ai)
#pragma unroll
            for (int m = 0; m < 4; ++m) {
                const int row = u.pm * BM + ai * HALF + wr * 64 + m * 16 + fr;
                const bf16_t* rr = res + (size_t)row * D; const float* gg = mod + (row >> 11) * 3072 + 2048;
                bf16_t* oo = out + (size_t)row * D;
#pragma unroll
                for (int bj = 0; bj < 2; ++bj) {
                    const int col = u.pn * BM + bj * HALF + wc * 32 + 8 * fq;
                    const u32x4 rb = *(const u32x4*)(rr + col);
                    const f32x4 r0 = (f32x4){bflo(rb.x), bfhi(rb.x), bflo(rb.y), bfhi(rb.y)}, r1 = (f32x4){bflo(rb.z), bfhi(rb.z), bflo(rb.w), bfhi(rb.w)};
                    const f32x4 g0 = *(const f32x4*)(gg + col), g1 = *(const f32x4*)(gg + col + 4);
                    const f32x4 v0 = r0 + g0 * acc[ai][bj][m][0], v1 = r1 + g1 * acc[ai][bj][m][1];
                    u32x4 w; w.x = cvt_pk_bf16(v0[0], v0[1]); w.y = cvt_pk_bf16(v0[2], v0[3]); w.z = cvt_pk_bf16(v1[0], v1[1]); w.w = cvt_pk_bf16(v1[2], v1[3]);
                    *(u32x4*)(oo + col) = w;
                }
            }
    }
};

struct EpiQKVG1 {
    static constexpr bool PERM = true, AFTER_DRAIN = false, XCHG = false;
    bf16_t* O; float* R;
    __device__ __forceinline__ void operator()(const f32x4 (&acc)[2][2][4][2], const Unit& u, int wr, int wc, int fr, int fq) const {
        const int pn = u.pn;
        if (pn == 12) {
            if (wc == 0) {
#pragma unroll
                for (int ai = 0; ai < 2; ++ai)
#pragma unroll
                    for (int m = 0; m < 4; ++m) {
                        const int row = u.pm * BM + ai * HALF + wr * 64 + m * 16 + fr;
                        *(f32x4*)(R + (size_t)row * 32 + 8 * fq) = acc[ai][0][m][0];
                        *(f32x4*)(R + (size_t)row * 32 + 8 * fq + 4) = acc[ai][0][m][1];
                    }
            }
            return;
        }
        const float sc = (pn < 2) ? 0.08838834764831845f : 1.f;
#pragma unroll
        for (int ai = 0; ai < 2; ++ai)
#pragma unroll
            for (int m = 0; m < 4; ++m) {
                const int row = u.pm * BM + ai * HALF + wr * 64 + m * 16 + fr;
#pragma unroll
                for (int bj = 0; bj < 2; ++bj) {
                    const int col = pn * BM + bj * HALF + wc * 32 + 8 * fq;
                    const f32x4 v0 = acc[ai][bj][m][0] * sc, v1 = acc[ai][bj][m][1] * sc;
                    u32x4 w; w.x = cvt_pk_bf16(v0[0], v0[1]); w.y = cvt_pk_bf16(v0[2], v0[3]); w.z = cvt_pk_bf16(v1[0], v1[1]); w.w = cvt_pk_bf16(v1[2], v1[3]);
                    *(u32x4*)(O + (size_t)row * N1 + col) = w;
                }
            }
    }
};

struct SchedPanel {
    int G, c;
    __device__ bool next(int i, Unit& u) const { const int L = i * G + c; if (L >= 288) return false; const int x = L & 7, j = L >> 3; u.pm = x + 8 * (j >> 2); u.pn = j & 3; return true; }
    __device__ __forceinline__ void a_ready(const Unit&) const {}
    __device__ __forceinline__ void done(const Unit&) const {}
};
struct EpiRes0Norm {
    static constexpr bool PERM = true, AFTER_DRAIN = false, XCHG = true;
    const float* res_lat; const float* res_ctx; const float* mod0; const float* mod1; const float* ng1; bf16_t* x1; bf16_t* h1; unsigned long long* ss;
    __device__ __forceinline__ void xchg(f32x4 (&acc)[2][2][4][2], const Unit& u, int wr, int wc, int fr, int fq, LAS unsigned char* scratch) const {
        LAS float* P = (LAS float*)scratch;
        LAS float* RS = P + 1024;
        const int tid = threadIdx.x;
        const int pmu = __builtin_amdgcn_readfirstlane(u.pm), pnu = __builtin_amdgcn_readfirstlane(u.pn), v = pmu < 64 ? (pmu >> 3) : 8;
        const float* rbase = pmu < 64 ? res_lat + (size_t)pmu * BM * D : res_ctx + (size_t)(pmu - 64) * BM * D;
        const int col0 = pnu * BM + wc * 32 + 8 * fq;
        const unsigned lofs = (unsigned)(fr * D + col0) * 2u;
        {
            f32x4 gt[2][2];
#pragma unroll
            for (int bj = 0; bj < 2; ++bj)
#pragma unroll
                for (int n = 0; n < 2; ++n) gt[bj][n] = *(const f32x4*)(mod0 + v * 3072 + 2048 + col0 + bj * HALF + 4 * n);
#pragma unroll
            for (int ai = 0; ai < 2; ++ai)
#pragma unroll
                for (int mp = 0; mp < 1; ++mp) {
                    f32x4 rres[4][2][2];
#pragma unroll
                    for (int mm = 0; mm < 4; ++mm) {
                        const int m = 4 * mp + mm;
                        const float* rr = (const float*)((const char*)(rbase + (size_t)(ai * HALF + wr * 64 + m * 16) * D) + 2u * lofs);
#pragma unroll
                        for (int bj = 0; bj < 2; ++bj) { rres[mm][bj][0] = *(const f32x4*)(rr + bj * HALF); rres[mm][bj][1] = *(const f32x4*)(rr + bj * HALF + 4); }
                    }
#pragma unroll
                    for (int mm = 0; mm < 4; ++mm) {
                        const int m = 4 * mp + mm;
                        const int rl = ai * HALF + wr * 64 + m * 16 + fr;
                        bf16_t* oo = (bf16_t*)((char*)(x1 + ((size_t)pmu * BM + ai * HALF + wr * 64 + m * 16) * D) + lofs);
                        float s2 = 0.f;
#pragma unroll
                        for (int bj = 0; bj < 2; ++bj) {
                            const f32x4 v0 = rres[mm][bj][0] + gt[bj][0] * acc[ai][bj][m][0], v1 = rres[mm][bj][1] + gt[bj][1] * acc[ai][bj][m][1];
                            acc[ai][bj][m][0] = v0; acc[ai][bj][m][1] = v1;
                            s2 += ((v0[0] * v0[0] + v0[1] * v0[1]) + (v0[2] * v0[2] + v0[3] * v0[3])) + ((v1[0] * v1[0] + v1[1] * v1[1]) + (v1[2] * v1[2] + v1[3] * v1[3]));
                            u32x4 w; w.x = cvt_pk_bf16(v0[0], v0[1]); w.y = cvt_pk_bf16(v0[2], v0[3]); w.z = cvt_pk_bf16(v1[0], v1[1]); w.w = cvt_pk_bf16(v1[2], v1[3]);
                            *(u32x4*)(oo + bj * HALF) = w;
                        }
                        s2 += __shfl_xor(s2, 16); s2 += __shfl_xor(s2, 32);
                        if (fq == 0) P[rl * 4 + wc] = s2;
                    }
                    __builtin_amdgcn_sched_barrier(0);
                }
        }
        __syncthreads();
        if (tid < 256) {
            const f32x4 p = *(const LAS f32x4*)(P + tid * 4);
            const float tot = (p[0] + p[1]) + (p[2] + p[3]);
            unsigned long long* a = ss + ((size_t)pmu * BM + tid);
            const unsigned long long mine = (1ull << 56) | (unsigned long long)(tot * 1048576.f + 0.5f);
            (void)__hip_atomic_fetch_add(a, mine, __ATOMIC_RELAXED, __HIP_MEMORY_SCOPE_AGENT);
            unsigned long long vv = __hip_atomic_load(a, __ATOMIC_RELAXED, __HIP_MEMORY_SCOPE_AGENT); unsigned sp = 0;
            while ((vv >> 56) < 4ull) { __builtin_amdgcn_s_sleep(1); vv = __hip_atomic_load(a, __ATOMIC_RELAXED, __HIP_MEMORY_SCOPE_AGENT); if (++sp > (1u << 22)) break; }
            const float sum = (float)(vv & ((1ull << 56) - 1ull)) * (1.f / 1048576.f);
            RS[tid] = rsqrtf(sum * (1.f / D) + EPS);
        }
        __syncthreads();
        {
            f32x4 gm[2][2], sh[2][2];
#pragma unroll
            for (int bj = 0; bj < 2; ++bj)
#pragma unroll
                for (int n = 0; n < 2; ++n) {
                    const int c = col0 + bj * HALF + 4 * n;
                    gm[bj][n] = *(const f32x4*)(ng1 + c) * (*(const f32x4*)(mod1 + v * 3072 + 1024 + c) + 1.f); sh[bj][n] = *(const f32x4*)(mod1 + v * 3072 + c);
                }
#pragma unroll
            for (int ai = 0; ai < 2; ++ai)
#pragma unroll
                for (int m = 0; m < 4; ++m) {
                    const int rl = ai * HALF + wr * 64 + m * 16 + fr;
                    const float rstd = RS[rl]; bf16_t* hh = (bf16_t*)((char*)(h1 + ((size_t)pmu * BM + ai * HALF + wr * 64 + m * 16) * D) + lofs);
#pragma unroll
                    for (int bj = 0; bj < 2; ++bj) {
                        const f32x4 y0 = (acc[ai][bj][m][0] * rstd) * gm[bj][0] + sh[bj][0], y1 = (acc[ai][bj][m][1] * rstd) * gm[bj][1] + sh[bj][1];
                        u32x4 w; w.x = cvt_pk_bf16(y0[0], y0[1]); w.y = cvt_pk_bf16(y0[2], y0[3]); w.z = cvt_pk_bf16(y1[0], y1[1]); w.w = cvt_pk_bf16(y1[2], y1[3]);
                        *(u32x4*)(hh + bj * HALF) = w;
                    }
                }
        }
        __syncthreads();
    }
};

struct EpiResNorm {
    static constexpr bool PERM = true, AFTER_DRAIN = true, XCHG = false;
    const bf16_t* res; const float* mod; const float* fg; float* out; unsigned long long* ss;
    __device__ __forceinline__ void fused(f32x4 (&acc)[2][2][4][2], const Unit& u, int wr, int wc, int fr, int fq, LAS unsigned char* lds, int wid, int lane) const {
        LAS float* P = (LAS float*)lds;
        LAS float* RS = P + 1024;
        const int tid = threadIdx.x;
#pragma unroll
        for (int ai = 0; ai < 2; ++ai)
#pragma unroll
            for (int m = 0; m < 4; ++m) {
                const int rl = ai * HALF + wr * 64 + m * 16 + fr; const int row = u.pm * BM + rl;
                const bf16_t* rr = res + (size_t)row * D; const float* gg = mod + (row >> 11) * 3072 + 2048;
                float s2 = 0.f;
#pragma unroll
                for (int bj = 0; bj < 2; ++bj) {
                    const int col = u.pn * BM + bj * HALF + wc * 32 + 8 * fq;
                    const u32x4 rb = *(const u32x4*)(rr + col);
                    const f32x4 r0 = (f32x4){bflo(rb.x), bfhi(rb.x), bflo(rb.y), bfhi(rb.y)}, r1 = (f32x4){bflo(rb.z), bfhi(rb.z), bflo(rb.w), bfhi(rb.w)};
                    const f32x4 g0 = *(const f32x4*)(gg + col), g1 = *(const f32x4*)(gg + col + 4);
                    const f32x4 v0 = r0 + g0 * acc[ai][bj][m][0], v1 = r1 + g1 * acc[ai][bj][m][1];
                    acc[ai][bj][m][0] = v0; acc[ai][bj][m][1] = v1;
                    s2 += ((v0[0] * v0[0] + v0[1] * v0[1]) + (v0[2] * v0[2] + v0[3] * v0[3])) + ((v1[0] * v1[0] + v1[1] * v1[1]) + (v1[2] * v1[2] + v1[3] * v1[3]));
                }
                s2 += __shfl_xor(s2, 16); s2 += __shfl_xor(s2, 32);
                if (fq == 0) P[rl * 4 + wc] = s2;
            }
        __syncthreads();
        if (tid < 256) {
            const f32x4 p = *(const LAS f32x4*)(P + tid * 4);
            const float tot = (p[0] + p[1]) + (p[2] + p[3]);
            unsigned long long* a = ss + (size_t)(u.pm * BM + tid);
            const unsigned long long mine = (1ull << 56) | (unsigned long long)(tot * 1048576.f + 0.5f);
            (void)__hip_atomic_fetch_add(a, mine, __ATOMIC_RELAXED, __HIP_MEMORY_SCOPE_AGENT);
            unsigned long long v = __hip_atomic_load(a, __ATOMIC_RELAXED, __HIP_MEMORY_SCOPE_AGENT); unsigned sp = 0;
            while ((v >> 56) < 4ull) { __builtin_amdgcn_s_sleep(1); v = __hip_atomic_load(a, __ATOMIC_RELAXED, __HIP_MEMORY_SCOPE_AGENT); if (++sp > (1u << 22)) break; }
            const float sum = (float)(v & ((1ull << 56) - 1ull)) * (1.f / 1048576.f);
            RS[tid] = rsqrtf(sum * (1.f / D) + EPS);
        }
        __syncthreads();
        f32x4 fgv[2][2];
#pragma unroll
        for (int bj = 0; bj < 2; ++bj)
#pragma unroll
            for (int n = 0; n < 2; ++n) fgv[bj][n] = *(const f32x4*)(fg + u.pn * BM + bj * HALF + wc * 32 + 8 * fq + 4 * n);
#pragma unroll
        for (int ai = 0; ai < 2; ++ai)
#pragma unroll
            for (int m = 0; m < 4; ++m) {
                const int rl = ai * HALF + wr * 64 + m * 16 + fr; const int row = u.pm * BM + rl;
                const float rstd = RS[rl]; float* oo = out + (size_t)row * D;
#pragma unroll
                for (int bj = 0; bj < 2; ++bj) {
                    const int col = u.pn * BM + bj * HALF + wc * 32 + 8 * fq;
#pragma unroll
                    for (int n = 0; n < 2; ++n) *(f32x4*)(oo + col + 4 * n) = (acc[ai][bj][m][n] * rstd) * fgv[bj][n];
                }
            }
    }
};

template <class Epi, class Sched_, bool ALIGN_EPI = false, bool SP2 = false>
__device__ __forceinline__ void gemm_phase(LAS unsigned char* lds, const Gemm g, const Sched_& S, const Epi& E) {
    const int tid = threadIdx.x, wid = __builtin_amdgcn_readfirstlane(tid >> 6), lane = tid & 63, wr = wid >> 2, wc = wid & 3, fr = lane & 15, fq = lane >> 4;
    const int K = g.K, nt = K / BK;
    unsigned voffA[2], voffB[2];
#pragma unroll
    for (int i = 0; i < 2; ++i) { int R, C; stage_rc(tid * 16 + i * 8192, R, C); const int Rb = Epi::PERM ? ((R & ~31) + perm32(R & 31)) : R;
        voffA[i] = (unsigned)(R * K + C) * 2u; voffB[i] = (unsigned)(Rb * K + C) * 2u; }
    const size_t kstep = (size_t)(BK * 2);
    const size_t hstep = (size_t)HALF * K * 2;
    const size_t tstep = 2 * hstep;
    const unsigned ldsw = (unsigned)wid * 1024u;
    const int aoff = lds_byte(wr * 64 + fr, fq * 8), boff = lds_byte(wc * 32 + fr, fq * 8);
#define PG8_SA(b, h) (((b) * 2 + (h)) * HTB)
#define PG8_SB(b, h) ((4 + (b) * 2 + (h)) * HTB)
#define PG8_STAGE(bufoff, gbase, voff) do { _Pragma("unroll") for (int _i = 0; _i < 2; ++_i) \
        __builtin_amdgcn_global_load_lds((const GAS unsigned*)((const char*)(gbase) + (voff)[_i]), (LAS unsigned*)(lds + (bufoff) + ldsw + _i * 8192), 16, 0, 0); } while (0)
#define PG8_LDA(dst, b, h) do { _Pragma("unroll") for (int m = 0; m < 4; ++m) _Pragma("unroll") for (int k = 0; k < 2; ++k) dst[m][k] = *(const LAS bf16x8*)(lds + PG8_SA(b, h) + aoff + m * 2048 + k * 1024); } while (0)
#define PG8_LDB(dst, b, h) do { _Pragma("unroll") for (int n = 0; n < 2; ++n) _Pragma("unroll") for (int k = 0; k < 2; ++k) dst[n][k] = *(const LAS bf16x8*)(lds + PG8_SB(b, h) + boff + n * 2048 + k * 1024); } while (0)
#define PG8_MMA(ai, bj, At, Bt) do { __builtin_amdgcn_s_setprio(1); _Pragma("unroll") for (int m = 0; m < 4; ++m) _Pragma("unroll") for (int n = 0; n < 2; ++n) _Pragma("unroll") for (int k = 0; k < 2; ++k) \
        acc[ai][bj][m][n] = __builtin_amdgcn_mfma_f32_16x16x32_bf16(Bt[n][k], At[m][k], acc[ai][bj][m][n], 0, 0, 0); __builtin_amdgcn_s_setprio(0); } while (0)
#define PG8_WAIT_V(n) asm volatile("s_waitcnt vmcnt(" #n ")" ::: "memory")
#define PG8_WAIT_L(n) asm volatile("s_waitcnt lgkmcnt(" #n ")" ::: "memory")
#define PG8_BAR __builtin_amdgcn_s_barrier()
#define PG8_SCHED __builtin_amdgcn_sched_barrier(0)
    Unit cur, nxt; int ui = 0;
    if (!S.next(0, cur)) return;
    f32x4 acc[2][2][4][2];
#pragma unroll
    for (int a = 0; a < 2; ++a)
#pragma unroll
        for (int b = 0; b < 2; ++b)
#pragma unroll
            for (int m = 0; m < 4; ++m)
#pragma unroll
                for (int n = 0; n < 2; ++n) acc[a][b][m][n] = (f32x4){0.f, 0.f, 0.f, 0.f};
    bf16x8 At[4][2], B0[2][2], B1[2][2];
    const char* cA = (const char*)g.A + (size_t)cur.pm * tstep; const char* cB = (const char*)g.Bt + (size_t)cur.pn * tstep;
    S.a_ready(cur);
    if constexpr (SP2) {
        PG8_STAGE(PG8_SB(0, 0), cB, voffB); PG8_STAGE(PG8_SB(0, 1), cB + hstep, voffB); PG8_STAGE(PG8_SA(0, 0), cA, voffA); PG8_STAGE(PG8_SA(0, 1), cA + hstep, voffA);
        if (wr == 1) PG8_BAR;
        PG8_WAIT_V(2); PG8_BAR;
        PG8_STAGE(PG8_SB(1, 0), cB + kstep, voffB); PG8_STAGE(PG8_SA(1, 0), cA + kstep, voffA); PG8_STAGE(PG8_SB(1, 1), cB + hstep + kstep, voffB);
        PG8_WAIT_V(6); PG8_BAR;
    } else {
        PG8_STAGE(PG8_SB(0, 0), cB, voffB); PG8_STAGE(PG8_SA(0, 0), cA, voffA); PG8_STAGE(PG8_SB(0, 1), cB + hstep, voffB); PG8_STAGE(PG8_SA(0, 1), cA + hstep, voffA);
        if (wr == 1) PG8_BAR;
        PG8_WAIT_V(4); PG8_BAR;
        PG8_STAGE(PG8_SB(1, 0), cB + kstep, voffB); PG8_STAGE(PG8_SA(1, 0), cA + kstep, voffA); PG8_STAGE(PG8_SB(1, 1), cB + hstep + kstep, voffB);
        PG8_WAIT_V(6); PG8_BAR;
    }
    for (;;) {
        const bool has_next = S.next(ui + 1, nxt);
        const char* nA = has_next ? (const char*)g.A + (size_t)nxt.pm * tstep : cA; const char* nB = has_next ? (const char*)g.Bt + (size_t)nxt.pn * tstep : cB;
        for (int t = 0; t < nt; t += 2) {
            const bool last = (t == nt - 2);
            const char* a1 = cA + (size_t)(t + 1) * kstep;
            const char* a2 = last ? nA : cA + (size_t)(t + 2) * kstep; const char* b2 = last ? nB : cB + (size_t)(t + 2) * kstep;
            const char* a3 = a2 + kstep; const char* b3 = b2 + kstep;
            if (last && has_next) S.a_ready(nxt);
            if constexpr (SP2) {
            PG8_LDB(B0, 0, 0); PG8_LDB(B1, 0, 1); PG8_SCHED; PG8_LDA(At, 0, 0); PG8_STAGE(PG8_SA(1, 1), a1 + hstep, voffA);
            PG8_WAIT_V(8); PG8_WAIT_L(0); PG8_BAR; PG8_MMA(0, 0, At, B0); PG8_MMA(0, 1, At, B1); PG8_BAR; PG8_SCHED;
            PG8_LDA(At, 0, 1); PG8_STAGE(PG8_SB(0, 0), b2, voffB); PG8_STAGE(PG8_SB(0, 1), b2 + hstep, voffB); PG8_STAGE(PG8_SA(0, 0), a2, voffA);
            PG8_WAIT_V(8); PG8_WAIT_L(0); PG8_BAR; PG8_MMA(1, 0, At, B0); PG8_MMA(1, 1, At, B1); PG8_BAR; PG8_SCHED;
            PG8_LDB(B0, 1, 0); PG8_LDB(B1, 1, 1); PG8_SCHED; PG8_LDA(At, 1, 0); PG8_STAGE(PG8_SA(0, 1), a2 + hstep, voffA);
            PG8_WAIT_V(8); PG8_WAIT_L(0); PG8_BAR; PG8_MMA(0, 0, At, B0); PG8_MMA(0, 1, At, B1); PG8_BAR; PG8_SCHED;
            PG8_LDA(At, 1, 1); PG8_STAGE(PG8_SB(1, 0), b3, voffB); PG8_STAGE(PG8_SB(1, 1), b3 + hstep, voffB); PG8_STAGE(PG8_SA(1, 0), a3, voffA);
            PG8_WAIT_V(8); PG8_WAIT_L(0); PG8_BAR; PG8_MMA(1, 0, At, B0); PG8_MMA(1, 1, At, B1); PG8_BAR; PG8_SCHED;
            } else {
            PG8_LDB(B0, 0, 0); PG8_SCHED; PG8_LDA(At, 0, 0); PG8_STAGE(PG8_SA(1, 1), a1 + hstep, voffA);
            PG8_WAIT_L(8); PG8_BAR; PG8_WAIT_L(0); PG8_MMA(0, 0, At, B0); PG8_BAR; PG8_SCHED;
            PG8_LDB(B1, 0, 1); PG8_STAGE(PG8_SB(0, 0), b2, voffB);
            PG8_BAR; PG8_WAIT_L(0); PG8_MMA(0, 1, At, B1); PG8_BAR;
            PG8_LDA(At, 0, 1); PG8_STAGE(PG8_SA(0, 0), a2, voffA);
            PG8_BAR; PG8_WAIT_L(0); PG8_MMA(1, 0, At, B0); PG8_BAR; PG8_SCHED;
            PG8_STAGE(PG8_SB(0, 1), b2 + hstep, voffB);
            PG8_WAIT_V(6); PG8_BAR; PG8_MMA(1, 1, At, B1); PG8_BAR;
            PG8_LDB(B0, 1, 0); PG8_SCHED; PG8_LDA(At, 1, 0); PG8_STAGE(PG8_SA(0, 1), a2 + hstep, voffA);
            PG8_WAIT_L(8); PG8_BAR; PG8_WAIT_L(0); PG8_MMA(0, 0, At, B0); PG8_BAR; PG8_SCHED;
            PG8_LDB(B1, 1, 1); PG8_STAGE(PG8_SB(1, 0), b3, voffB);
            PG8_BAR; PG8_WAIT_L(0); PG8_MMA(0, 1, At, B1); PG8_BAR;
            PG8_LDA(At, 1, 1); PG8_STAGE(PG8_SA(1, 0), a3, voffA);
            PG8_BAR; PG8_WAIT_L(0); PG8_MMA(1, 0, At, B0); PG8_BAR; PG8_SCHED;
            PG8_STAGE(PG8_SB(1, 1), b3 + hstep, voffB);
            PG8_WAIT_V(6); PG8_BAR; PG8_MMA(1, 1, At, B1); PG8_BAR;
            }
        }
        if constexpr (ALIGN_EPI) { if (wr == 0) PG8_BAR; }
        if constexpr (Epi::XCHG) { E.xchg(acc, cur, wr, wc, fr, fq, lds + STAGE_BYTES); S.done(cur); }
        else if constexpr (!Epi::AFTER_DRAIN) { E(acc, cur, wr, wc, fr, fq); S.done(cur); }
        if (!has_next) break;
#pragma unroll
        for (int a = 0; a < 2; ++a)
#pragma unroll
            for (int b = 0; b < 2; ++b)
#pragma unroll
                for (int m = 0; m < 4; ++m)
#pragma unroll
                    for (int n = 0; n < 2; ++n) acc[a][b][m][n] = (f32x4){0.f, 0.f, 0.f, 0.f};
        cur = nxt; cA = nA; cB = nB; ++ui;
        if constexpr (ALIGN_EPI) { if (wr == 1) PG8_BAR; }
    }
    PG8_WAIT_V(0);
    if constexpr (!ALIGN_EPI) { if (wr == 0) PG8_BAR; }
    PG8_BAR;
    if constexpr (Epi::AFTER_DRAIN) { E.fused(acc, cur, wr, wc, fr, fq, lds, wid, lane); S.done(cur); }
#undef PG8_SA
#undef PG8_SB
#undef PG8_STAGE
#undef PG8_LDA
#undef PG8_LDB
#undef PG8_MMA
#undef PG8_WAIT_V
#undef PG8_WAIT_L
#undef PG8_BAR
#undef PG8_SCHED
}
}

struct Args { const float* in[23]; float* out; unsigned char* ws; int ph_lo, ph_hi; };
enum { I_X = 0, I_C, I_CTX, I_CCTX, I_L0_NG, I_L0_WADA, I_L0_BADA, I_L0_WIN, I_L0_SINK, I_L0_WOUT,
       I_L1_NG, I_L1_WADA, I_L1_BADA, I_L1_WIN, I_L1_WA1F, I_L1_WA2F, I_L1_BAF, I_L1_WA1B, I_L1_WA2B, I_L1_BAB, I_L1_HNG, I_L1_WOUT, I_FNG };

__device__ __forceinline__ void p0_transpose_item(const float* W, int K, int N, bf16_t* WT, LAS float* scr, int item, int lane) {
    const int nblk = N / 32, kb = item / nblk, nb = item % nblk, k0 = 64 * kb, n0 = 32 * nb;
#pragma unroll 8
    for (int i = 0; i < 32; ++i) { const int kk = 2 * i + (lane >> 5); scr[kk * 33 + (lane & 31)] = W[(size_t)(k0 + kk) * N + n0 + (lane & 31)]; }
    asm volatile("s_waitcnt lgkmcnt(0)" ::: "memory");
    const int c = lane & 7;
#pragma unroll
    for (int j = 0; j < 4; ++j) { const int n = (lane >> 3) + 8 * j; const LAS float* s = scr + (8 * c) * 33 + n;
        u32x4 o; o.x = cvt_pk_bf16(s[0 * 33], s[1 * 33]); o.y = cvt_pk_bf16(s[2 * 33], s[3 * 33]); o.z = cvt_pk_bf16(s[4 * 33], s[5 * 33]); o.w = cvt_pk_bf16(s[6 * 33], s[7 * 33]);
        *(u32x4*)(WT + (size_t)(n0 + n) * K + k0 + 8 * c) = o; }
    asm volatile("s_waitcnt lgkmcnt(0)" ::: "memory");
}

__device__ __forceinline__ void p0_prologue(const Args& a, LAS unsigned char* lds, int bid, int nb, int part) {
    const int tid = threadIdx.x, lane = tid & 63, wave = tid >> 6;
    unsigned char* ws = a.ws;
    {
        LAS float* sc = (LAS float*)lds;
        LAS float* red = sc + 9 * 1024;
        bool loaded = false;
        const int layer = part;
        const int COLS = part ? 32 : 16, NKG = 512 / COLS, NGRP = 3072 / COLS;
        for (int grp = bid; grp < NGRP; grp += nb) {
            if (!loaded) {
                for (int i = tid; i < 9 * 1024; i += 512) { const float cv = i < 8192 ? a.in[I_C][i] : a.in[I_CCTX][i - 8192]; sc[i] = silu_f(cv); }
                loaded = true;
            }
            __syncthreads();
            const int n0 = grp * COLS;
            const float* W = layer ? a.in[I_L1_WADA] : a.in[I_L0_WADA]; const float* bias = layer ? a.in[I_L1_BADA] : a.in[I_L0_BADA];
            float* mod = (float*)(ws + (layer ? WS_MOD1 : WS_MOD0));
            const int col = tid & (COLS - 1), kg = tid / COLS;
            float acc[9];
#pragma unroll
            for (int v = 0; v < 9; ++v) acc[v] = 0.f;
            for (int k0 = kg; k0 < 1024; k0 += 8 * NKG) {
                float w[8];
#pragma unroll
                for (int u = 0; u < 8; ++u) w[u] = W[(size_t)(k0 + u * NKG) * 3072 + n0 + col];
#pragma unroll
                for (int u = 0; u < 8; ++u)
#pragma unroll
                    for (int v = 0; v < 9; ++v) acc[v] += sc[v * 1024 + k0 + u * NKG] * w[u];
            }
#pragma unroll
            for (int v = 0; v < 9; ++v) red[(kg * 9 + v) * COLS + col] = acc[v];
            __syncthreads();
            if (tid < 9 * COLS) {
                const int v = tid / COLS, cc = tid & (COLS - 1); float s2 = bias[n0 + cc];
                for (int g2 = 0; g2 < NKG; ++g2) s2 += red[(g2 * 9 + v) * COLS + cc];
                if (layer) mod[v * 3072 + n0 + cc] = s2;
                else __hip_atomic_store((unsigned*)mod + v * 3072 + n0 + cc, __builtin_bit_cast(unsigned, s2) | 1u, __ATOMIC_RELAXED, __HIP_MEMORY_SCOPE_AGENT);
            }
        }
        __syncthreads();
    }
    if (part == 0) {
        float* cosT = (float*)(ws + WS_ROPE); float* sinT = cosT + 1024;
        const int gt = bid * 512 + tid;
        if (gt < 1024) { const int p = gt >> 4, f = gt & 15; const float inv = powf(10000.f, -(float)f / 16.f); const float ang = (float)p * inv; cosT[gt] = cosf(ang); sinT[gt] = sinf(ang); }
    } else {
        bf16_t* WT1 = (bf16_t*)(ws + WS_WT1);
        for (int i = bid * 512 + tid; i < 256 * 1024; i += nb * 512) {
            const int r = i >> 10, k = i & 1023; float v = 0.f;
            if (r < 16) v = a.in[I_L1_WA1F][k * 16 + r]; else if (r < 32) v = a.in[I_L1_WA1B][k * 16 + (r - 16)];
            WT1[(size_t)(3072 + r) * 1024 + k] = f2bf(v);
        }
    }
    {
        LAS float* scr = (LAS float*)(lds + wave * 16384);
        const int gw = bid * 8 + wave, NGW = nb * 8;
        constexpr int I0 = 16 * (N0 / 32), IO = 16 * (D / 32), I1 = 16 * (N1 / 32);
        if (part == 0) {
            for (int it = gw; it < I0; it += NGW) p0_transpose_item(a.in[I_L0_WIN], D, N0, (bf16_t*)(ws + WS_WT0), scr, it, lane);
        } else {
            for (int it = gw; it < IO + I1 + IO; it += NGW) {
                int r = it;
                if (r < IO) { p0_transpose_item(a.in[I_L0_WOUT], D, D, (bf16_t*)(ws + WS_WO0), scr, r, lane); continue; } r -= IO;
                if (r < I1) { p0_transpose_item(a.in[I_L1_WIN], D, N1, (bf16_t*)(ws + WS_WT1), scr, r, lane); continue; } r -= I1;
                p0_transpose_item(a.in[I_L1_WOUT], D, D, (bf16_t*)(ws + WS_WO1), scr, r, lane);
            }
        }
    }
}

__device__ __forceinline__ void norm_mod_phase(const float* xl, const float* xc, const float* ng, const float* mod, bf16_t* H, int G) {
    const int lane = threadIdx.x & 63, wave = threadIdx.x >> 6;
    for (int row = blockIdx.x * 8 + wave; row < MT; row += G * 8) {
        const float* xr = row < ML ? xl + (size_t)row * D : xc + (size_t)(row - ML) * D;
        const int v = row < ML ? (row >> 11) : 8;
        const float* sh = mod + v * 3072; const float* scl = sh + 1024;
        f32x4 x[4]; float ss = 0.f;
#pragma unroll
        for (int j = 0; j < 4; ++j) { x[j] = *(const f32x4*)(xr + 4 * lane + 256 * j); ss += (x[j][0] * x[j][0] + x[j][1] * x[j][1]) + (x[j][2] * x[j][2] + x[j][3] * x[j][3]); }
        const float rstd = rsqrtf(wave_sum(ss) * (1.f / D) + EPS);
#pragma unroll
        for (int j = 0; j < 4; ++j) {
            const int c = 4 * lane + 256 * j;
            const f32x4 g = *(const f32x4*)(ng + c), s1 = *(const f32x4*)(scl + c), s0 = *(const f32x4*)(sh + c);
            const f32x4 y = (x[j] * rstd) * g * (s1 + 1.f) + s0;
            u32x2 w; w.x = cvt_pk_bf16(y[0], y[1]); w.y = cvt_pk_bf16(y[2], y[3]);
            *(u32x2*)(H + (size_t)row * D + c) = w;
        }
    }
}

__device__ __forceinline__ void norm_mod_wait_phase(const float* xl, const float* xc, const float* ng, const float* mod, bf16_t* H, int G) {
    const int lane = threadIdx.x & 63, wave = threadIdx.x >> 6;
    const int gw = blockIdx.x * 8 + wave, NW = G * 8;
    const int v = gw % 9, wi = gw / 9, nv = (NW - v + 8) / 9;
    if (wi >= 2048) return;
    const float* xbase = v < 8 ? xl + (size_t)v * SEQ * D : xc;
    bf16_t* hbase = H + (size_t)(v < 8 ? v * SEQ : ML) * D;
    f32x4 gm[4], sh[4];
    {
        unsigned* mw = (unsigned*)mod + v * 3072;
#pragma unroll
        for (int j = 0; j < 4; ++j) {
            const int c = 4 * lane + 256 * j;
            const f32x4 g = *(const f32x4*)(ng + c);
#pragma unroll
            for (int i = 0; i < 4; ++i) {
                unsigned a = __hip_atomic_load(mw + c + i, __ATOMIC_RELAXED, __HIP_MEMORY_SCOPE_AGENT), bsc = __hip_atomic_load(mw + 1024 + c + i, __ATOMIC_RELAXED, __HIP_MEMORY_SCOPE_AGENT); unsigned sp = 0;
                while ((a == 0u || bsc == 0u) && ++sp < (1u << 22)) { __builtin_amdgcn_s_sleep(2); a = __hip_atomic_load(mw + c + i, __ATOMIC_RELAXED, __HIP_MEMORY_SCOPE_AGENT); bsc = __hip_atomic_load(mw + 1024 + c + i, __ATOMIC_RELAXED, __HIP_MEMORY_SCOPE_AGENT); }
                sh[j][i] = __builtin_bit_cast(float, a); gm[j][i] = g[i] * (__builtin_bit_cast(float, bsc) + 1.f);
            }
        }
    }
    for (int r = wi; r < 2048; r += nv) {
        const float* xr = xbase + (size_t)r * D;
        f32x4 x[4]; float ss = 0.f;
#pragma unroll
        for (int j = 0; j < 4; ++j) { x[j] = *(const f32x4*)(xr + 4 * lane + 256 * j); ss += (x[j][0] * x[j][0] + x[j][1] * x[j][1]) + (x[j][2] * x[j][2] + x[j][3] * x[j][3]); }
        const float rstd = rsqrtf(wave_sum(ss) * (1.f / D) + EPS);
#pragma unroll
        for (int j = 0; j < 4; ++j) {
            const f32x4 y = (x[j] * rstd) * gm[j] + sh[j];
            u32x2 w; w.x = cvt_pk_bf16(y[0], y[1]); w.y = cvt_pk_bf16(y[2], y[3]);
            *(u32x2*)(hbase + (size_t)r * D + 4 * lane + 256 * j) = w;
        }
    }
}

__device__ __forceinline__ void norm_mod_bf16_phase(const bf16_t* X, const float* ng, const float* mod, bf16_t* H, int G) {
    const int lane = threadIdx.x & 63, wave = threadIdx.x >> 6;
    for (int row = blockIdx.x * 8 + wave; row < MT; row += G * 8) {
        const bf16_t* xr = X + (size_t)row * D;
        const int v = row < ML ? (row >> 11) : 8;
        const float* sh = mod + v * 3072; const float* scl = sh + 1024;
        float x[16]; float ss = 0.f;
#pragma unroll
        for (int j = 0; j < 2; ++j) {
            const u32x4 u = *(const u32x4*)(xr + 8 * lane + 512 * j);
#pragma unroll
            for (int i = 0; i < 4; ++i) { x[8 * j + 2 * i] = bflo(u[i]); x[8 * j + 2 * i + 1] = bfhi(u[i]); }
        }
#pragma unroll
        for (int i = 0; i < 16; ++i) ss += x[i] * x[i];
        const float rstd = rsqrtf(wave_sum(ss) * (1.f / D) + EPS);
#pragma unroll
        for (int j = 0; j < 2; ++j) {
            const int c = 8 * lane + 512 * j;
            unsigned w[4];
#pragma unroll
            for (int i = 0; i < 2; ++i) {
                const f32x4 g = *(const f32x4*)(ng + c + 4 * i), s1 = *(const f32x4*)(scl + c + 4 * i), s0 = *(const f32x4*)(sh + c + 4 * i);
                const f32x4 xv = (f32x4){x[8 * j + 4 * i], x[8 * j + 4 * i + 1], x[8 * j + 4 * i + 2], x[8 * j + 4 * i + 3]};
                const f32x4 y = (xv * rstd) * g * (s1 + 1.f) + s0;
                w[2 * i] = cvt_pk_bf16(y[0], y[1]); w[2 * i + 1] = cvt_pk_bf16(y[2], y[3]);
            }
            *(u32x4*)(H + (size_t)row * D + c) = (u32x4){w[0], w[1], w[2], w[3]};
        }
    }
}

__device__ __forceinline__ void attn_phase(const bf16_t* QKVG, const float* sink, bf16_t* OG, LAS unsigned char* lds, int G) {
    const int tid = threadIdx.x, lane = tid & 63, wave = tid >> 6, fr = lane & 15, fq = lane >> 4;
    LAS bf16_t* sK = (LAS bf16_t*)lds;
    constexpr float LOG2E = 1.4426950408889634f;
    for (int unit = blockIdx.x; unit < 576; unit += G) {
        int b, kvh, qc, rowbase; bool lat;
        if (unit < 64) { lat = true; const int gk = unit >> 2, e = unit & 3; b = gk >> 1; kvh = gk & 1; qc = e < 2 ? e : 28 + e; rowbase = b * SEQ + qc * 64; }
        else if (unit < 512) { lat = true; const int v = unit - 64, gk = v / 28; b = gk >> 1; kvh = gk & 1; qc = 2 + v % 28; rowbase = b * SEQ + qc * 64; }
        else { const int u2 = unit - 512; lat = false; b = u2 >> 3; kvh = (u2 >> 2) & 1; qc = u2 & 3; rowbase = ML + b * CTXL + qc * 64; }
        const int head = kvh * 8 + wave;
        bf16x8 Bq[4][2];
#pragma unroll
        for (int qt = 0; qt < 4; ++qt)
#pragma unroll
            for (int ks = 0; ks < 2; ++ks) Bq[qt][ks] = *(const bf16x8*)(QKVG + (size_t)(rowbase + qt * 16 + fr) * N0 + head * 64 + ks * 32 + fq * 8);
        float mfix[4], lrun[4]; f32x4 O[4][4];
        const float sk2 = sink[head] * LOG2E;
#pragma unroll
        for (int qt = 0; qt < 4; ++qt) { mfix[qt] = 0.f; lrun[qt] = 0.f;
#pragma unroll
            for (int dt = 0; dt < 4; ++dt) O[dt][qt] = (f32x4){0.f, 0.f, 0.f, 0.f}; }
        const int jlo = lat ? (qc < 2 ? 2 - qc : 0) : 0, jhi = lat ? (33 - qc < 4 ? 33 - qc : 4) : -1, nloc = jhi - jlo + 1, T = nloc + 4;
#define ATT_ROW(n_) ((n_) < nloc ? b * SEQ + 64 * (qc - 2 + jlo + (n_)) : ML + b * CTXL + 64 * ((n_) - nloc))
#define ATT_LOAD(n_) do { const bf16_t* src_ = QKVG + (size_t)(ATT_ROW(n_) + lkey) * N0 + 1024 + kvh * 64 + lch * 8; pkv = *(const u32x4*)src_; pvv = *(const u32x4*)(src_ + 128); } while (0)
#define ATT_STAGE(buf_) do { *(LAS u32x4*)(sK + (buf_) * ABUF + lkey * 72 + lch * 8) = pkv; *(LAS u32x4*)(sK + (buf_) * ABUF + 64 * 72 + lkey * 72 + lch * 8) = pvv; } while (0)
#define ATT_H2(buf_) do { const LAS bf16_t* cV_ = sK + (buf_) * ABUF + 64 * 72; \
            _Pragma("unroll") for (int dt = 0; dt < 4; ++dt) _Pragma("unroll") for (int s2 = 0; s2 < 2; ++s2) { \
                const s16x4 lo_ = lds_tr4(cV_ + (32 * s2 + 4 * fq + (fr >> 2)) * 72 + dt * 16 + 4 * (fr & 3)), hi_ = lds_tr4(cV_ + (32 * s2 + 16 + 4 * fq + (fr >> 2)) * 72 + dt * 16 + 4 * (fr & 3)); \
                const bf16x8 av_ = __builtin_shufflevector(lo_, hi_, 0, 1, 2, 3, 4, 5, 6, 7); \
                _Pragma("unroll") for (int qt = 0; qt < 4; ++qt) O[dt][qt] = __builtin_amdgcn_mfma_f32_16x16x32_bf16(av_, Bp[s2][qt], O[dt][qt], 0, 0, 0); } } while (0)
        constexpr int ABUF = 2 * 64 * 72;
        const int lkey = tid >> 3, lch = tid & 7;
        const int grp = __builtin_amdgcn_readfirstlane(wave >> 2);
        u32x4 pkv, pvv;
        ATT_LOAD(0);
        __syncthreads();
        ATT_STAGE(0);
        ATT_LOAD(1);
        ATT_STAGE(1);
        if (T > 2) ATT_LOAD(2);
        __syncthreads();
        bf16x8 Bp[2][4];
        int bcur = 0;
#define ATT_NEXT_STAGE() do { if (n + 2 < T) { const int b2_ = bcur == 0 ? 2 : bcur - 1; ATT_STAGE(b2_); if (n + 3 < T) ATT_LOAD(n + 3); } } while (0)
        for (int n = 0; n < T; ++n) {
            if (grp == 0) { LDS_BARRIER(); ATT_NEXT_STAGE(); }
            const int jj = jlo + n; const int kind = (n < nloc) ? (jj == 0 ? 1 : (jj == 4 ? 2 : 0)) : 0;
            const LAS bf16_t* cK = sK + bcur * ABUF;
#pragma unroll
            for (int hq = 0; hq < 2; ++hq) {
                f32x4 St[4][2];
#pragma unroll
                for (int kt = 0; kt < 4; ++kt) {
                    const bf16x8 a0 = *(const LAS bf16x8*)(cK + (kt * 16 + fr) * 72 + fq * 8), a1 = *(const LAS bf16x8*)(cK + (kt * 16 + fr) * 72 + 32 + fq * 8);
#pragma unroll
                    for (int q2 = 0; q2 < 2; ++q2) {
                        const float ci = -mfix[2 * hq + q2];
                        f32x4 c = (f32x4){ci, ci, ci, ci};
                        c = __builtin_amdgcn_mfma_f32_16x16x32_bf16(a0, Bq[2 * hq + q2][0], c, 0, 0, 0);
                        c = __builtin_amdgcn_mfma_f32_16x16x32_bf16(a1, Bq[2 * hq + q2][1], c, 0, 0, 0);
                        St[kt][q2] = c;
                    }
                }
                if (kind != 0) {
#pragma unroll
                    for (int kt = 0; kt < 4; ++kt)
#pragma unroll
                        for (int q2 = 0; q2 < 2; ++q2)
#pragma unroll
                            for (int r = 0; r < 4; ++r) { const int kk = kt * 16 + 4 * fq + r, qq = (2 * hq + q2) * 16 + fr; const bool ok = (kind == 1) ? (kk >= qq) : (kk <= qq); if (!ok) St[kt][q2][r] = -1e30f; }
                }
#pragma unroll
                for (int q2 = 0; q2 < 2; ++q2) {
                    const int qt = 2 * hq + q2;
                    if (n == 0) {
                        float mx = -1e30f;
#pragma unroll
                        for (int kt = 0; kt < 4; ++kt)
#pragma unroll
                            for (int r = 0; r < 4; ++r) mx = fmaxf(mx, St[kt][q2][r]);
                        mx = fmaxf(mx, __shfl_xor(mx, 16)); mx = fmaxf(mx, __shfl_xor(mx, 32));
                        const float mf = fmaxf(mx, sk2);
                        mfix[qt] = mf; lrun[qt] = (fq == 0) ? __builtin_amdgcn_exp2f(sk2 - mf) : 0.f;
#pragma unroll
                        for (int kt = 0; kt < 4; ++kt) St[kt][q2] = St[kt][q2] - mf;
                    }
                    float ls = 0.f;
#pragma unroll
                    for (int kt = 0; kt < 4; ++kt)
#pragma unroll
                        for (int r = 0; r < 4; ++r) { const float p = __builtin_amdgcn_exp2f(St[kt][q2][r]); St[kt][q2][r] = p; ls += p; asm("" : "+v"(ls)); }
                    lrun[qt] += ls;
#pragma unroll
                    for (int s = 0; s < 2; ++s) {
                        u32x4 w; w.x = cvt_pk_bf16(St[2 * s][q2][0], St[2 * s][q2][1]); w.y = cvt_pk_bf16(St[2 * s][q2][2], St[2 * s][q2][3]);
                        w.z = cvt_pk_bf16(St[2 * s + 1][q2][0], St[2 * s + 1][q2][1]); w.w = cvt_pk_bf16(St[2 * s + 1][q2][2], St[2 * s + 1][q2][3]);
                        Bp[s][qt] = __builtin_bit_cast(bf16x8, w);
                    }
                }
            }
            if (grp == 1) { LDS_BARRIER(); ATT_NEXT_STAGE(); }
            ATT_H2(bcur);
            bcur = bcur == 2 ? 0 : bcur + 1;
        }
#undef ATT_NEXT_STAGE
#undef ATT_ROW
#undef ATT_LOAD
#undef ATT_STAGE
#undef ATT_H2
        u32x2 gv[4][4];
#pragma unroll
        for (int qt = 0; qt < 4; ++qt)
#pragma unroll
            for (int dt = 0; dt < 4; ++dt) gv[qt][dt] = *(const u32x2*)(QKVG + (size_t)(rowbase + qt * 16 + fr) * N0 + 1280 + head * 64 + dt * 16 + 4 * fq);
#pragma unroll
        for (int qt = 0; qt < 4; ++qt) {
            float l = lrun[qt]; l += __shfl_xor(l, 16); l += __shfl_xor(l, 32);
            const float inv = __builtin_amdgcn_rcpf(l);
            const size_t row = (size_t)(rowbase + qt * 16 + fr);
#pragma unroll
            for (int dt = 0; dt < 4; ++dt) {
                const int dcol = head * 64 + dt * 16 + 4 * fq;
                const u32x2 g2 = gv[qt][dt];
                const float o0 = O[dt][qt][0] * inv * silu_f(bflo(g2.x)), o1 = O[dt][qt][1] * inv * silu_f(bfhi(g2.x));
                const float o2 = O[dt][qt][2] * inv * silu_f(bflo(g2.y)), o3 = O[dt][qt][3] * inv * silu_f(bfhi(g2.y));
                u32x2 w; w.x = cvt_pk_bf16(o0, o1); w.y = cvt_pk_bf16(o2, o3);
                *(u32x2*)(OG + row * D + dcol) = w;
            }
        }
    }
    __syncthreads();
}

__device__ __forceinline__ float log_sigmoid_f(float z) { return fminf(z, 0.f) - __logf(1.f + __expf(-fabsf(z))); }
__device__ __forceinline__ void gla_prep_phase(const Args& a, bf16_t* QKVG, const float* R, bf16_t* QDB, bf16_t* KIB, float* DEC, LAS unsigned char* lds, int G) {
    const int tid = threadIdx.x, d = tid & 127, tq = tid >> 7;
    LAS float* rS = (LAS float*)lds;
    LAS float* totS = rS + 2048;
    for (int item = blockIdx.x; item < 1152; item += G) {
        const int b = item / 144, rem = item % 144, h = rem / 36, cidx = rem % 36;
        const int row0 = cidx < 4 ? ML + b * CTXL + 64 * cidx : b * SEQ + 64 * (cidx - 4);
        __syncthreads();
        *(LAS f32x4*)(rS + tid * 4) = *(const f32x4*)(R + (size_t)(row0 + (tid >> 3)) * 32 + (tid & 7) * 4);
        bf16_t kraw[16], qraw[16];
#pragma unroll
        for (int tt = 0; tt < 16; ++tt) {
            const bf16_t* qk = QKVG + (size_t)(row0 + 16 * tq + tt) * N1 + h * 128 + d;
            kraw[tt] = qk[512]; qraw[tt] = (cidx >= 4) ? qk[0] : (bf16_t)0;
        }
        float wf[16], wb[16];
#pragma unroll
        for (int j = 0; j < 16; ++j) { wf[j] = a.in[I_L1_WA2F][j * 512 + h * 128 + d]; wb[j] = a.in[I_L1_WA2B][j * 512 + h * 128 + d]; }
        const float baf = a.in[I_L1_BAF][h * 128 + d], bab = a.in[I_L1_BAB][h * 128 + d];
        __syncthreads();
        float laf[16], lab[16];
#pragma unroll
        for (int tt = 0; tt < 16; ++tt) {
            const LAS float* rr = rS + (16 * tq + tt) * 32;
            float zf = baf, zb = bab;
#pragma unroll
            for (int j4 = 0; j4 < 4; ++j4) {
                const f32x4 rf = *(const LAS f32x4*)(rr + 4 * j4), rb = *(const LAS f32x4*)(rr + 16 + 4 * j4);
#pragma unroll
                for (int j = 0; j < 4; ++j) { zf += rf[j] * wf[4 * j4 + j]; zb += rb[j] * wb[4 * j4 + j]; }
            }
            laf[tt] = log_sigmoid_f(zf) * (1.f / 16.f); lab[tt] = log_sigmoid_f(zb) * (1.f / 16.f);
        }
#pragma unroll
        for (int tt = 1; tt < 16; ++tt) laf[tt] += laf[tt - 1];
#pragma unroll
        for (int tt = 14; tt >= 0; --tt) lab[tt] += lab[tt + 1];
        totS[tq * 128 + d] = laf[15]; totS[512 + tq * 128 + d] = lab[0];
        __syncthreads();
        float offf = 0.f, offb = 0.f, totf = 0.f, totb = 0.f;
#pragma unroll
        for (int q2 = 0; q2 < 4; ++q2) { const float tf = totS[q2 * 128 + d], tb = totS[512 + q2 * 128 + d]; totf += tf; totb += tb; if (q2 < tq) offf += tf; if (q2 > tq) offb += tb; }
        if (tq == 0) { DEC[(size_t)(((0 * 8 + b) * 4 + h) * 36 + cidx) * 128 + d] = __expf(totf); DEC[(size_t)(((1 * 8 + b) * 4 + h) * 36 + cidx) * 128 + d] = __expf(totb); }
#pragma unroll
        for (int tt = 0; tt < 16; ++tt) {
            const size_t row = (size_t)(row0 + 16 * tq + tt);
            const float cf = laf[tt] + offf, cb = lab[tt] + offb;
            bf16_t* qk = QKVG + row * N1 + h * 128 + d;
            const float k = bf2f(kraw[tt]);
            qk[512] = f2bf(k * __expf(-cf));
            KIB[row * 512 + h * 128 + d] = f2bf(k * __expf(-cb));
            if (cidx >= 4) { const float q = bf2f(qraw[tt]); qk[0] = f2bf(q * __expf(cf)); QDB[row * 512 + h * 128 + d] = f2bf(q * __expf(cb)); }
        }
    }
    __syncthreads();
}

__device__ __forceinline__ void gla_phase(const bf16_t* QKVG, const bf16_t* QDB, const bf16_t* KIB, const float* DEC, bf16_t* OFB, LAS unsigned char* lds, int G) {
    const int tid = threadIdx.x, lane = tid & 63, wave = tid >> 6, fr = lane & 15, fq = lane >> 4;
    const int et = wave & 3, hf = __builtin_amdgcn_readfirstlane(wave >> 2);
    constexpr int IMG = 2 * 64 * 136 + 64 * 72;
    LAS bf16_t* IMG0 = (LAS bf16_t*)lds;
    LAS bf16_t* AL = IMG0 + 2 * IMG;
    LAS float* DC0 = (LAS float*)(AL + 64 * 72);
    LAS float* OX = DC0 + 256;
    for (int unit = blockIdx.x; unit < 256; unit += G) {
        const int xj = unit >> 3, eq = xj & 3, gsel = (xj >> 2) * 8 + (unit & 7), dir = gsel & 1, h = (gsel >> 1) & 3, b = gsel >> 3;
        const bf16_t* qd_base = dir ? QDB + h * 128 : QKVG + h * 128; const size_t qd_pitch = dir ? 512 : N1;
        const bf16_t* ki_base = dir ? KIB + h * 128 : QKVG + 512 + h * 128; const size_t ki_pitch = dir ? 512 : N1;
        const bf16_t* v_base = QKVG + 1024 + h * 256 + eq * 64;
        const float* dec_base = DEC + (size_t)(((dir * 8 + b) * 4 + h) * 36) * 128;
        bf16_t* OUT = OFB + (size_t)dir * ML * D + h * 256 + eq * 64;
        f32x4 S[4];
#pragma unroll
        for (int i = 0; i < 4; ++i) S[i] = (f32x4){0.f, 0.f, 0.f, 0.f};
        u32x4 pq[2], pk[2], pv; float pdec = 0.f;
#define GLA_LOAD(step_) do { const int cx_ = dir ? ((step_) < 4 ? 3 - (step_) : 39 - (step_)) : (step_); \
            const int r0_ = cx_ < 4 ? ML + b * CTXL + 64 * cx_ : b * SEQ + 64 * (cx_ - 4); \
            _Pragma("unroll") for (int i_ = 0; i_ < 2; ++i_) { const int idx_ = tid + 512 * i_, pr_ = idx_ >> 4, c16_ = idx_ & 15; const size_t gr_ = (size_t)(r0_ + (dir ? 63 - pr_ : pr_)); \
                pq[i_] = (cx_ >= 4) ? *(const u32x4*)(qd_base + gr_ * qd_pitch + c16_ * 8) : (u32x4){0u, 0u, 0u, 0u}; \
                pk[i_] = *(const u32x4*)(ki_base + gr_ * ki_pitch + c16_ * 8); } \
            { const int pr_ = tid >> 3, c8_ = tid & 7; pv = *(const u32x4*)(v_base + (size_t)(r0_ + (dir ? 63 - pr_ : pr_)) * N1 + c8_ * 8); } \
            if (tid < 128) pdec = dec_base[cx_ * 128 + tid]; } while (0)
#define GLA_STAGE(buf_) do { LAS bf16_t* q_ = IMG0 + (buf_) * IMG; \
            _Pragma("unroll") for (int i_ = 0; i_ < 2; ++i_) { const int idx_ = tid + 512 * i_, pr_ = idx_ >> 4, c16_ = idx_ & 15; \
                *(LAS u32x4*)(q_ + pr_ * 136 + c16_ * 8) = pq[i_]; *(LAS u32x4*)(q_ + 64 * 136 + pr_ * 136 + c16_ * 8) = pk[i_]; } \
            *(LAS u32x4*)(q_ + 2 * 64 * 136 + (tid >> 3) * 72 + (tid & 7) * 8) = pv; \
            if (tid < 128) DC0[(buf_) * 128 + tid] = pdec; } while (0)
        GLA_LOAD(0);
        __syncthreads();
        GLA_STAGE(0);
        GLA_LOAD(1);
        __syncthreads();
        for (int step = 0; step < 36; ++step) {
            const int cidx = dir ? (step < 4 ? 3 - step : 39 - step) : step;
            const bool lat = step >= 4;
            const int row0 = cidx < 4 ? ML + b * CTXL + 64 * cidx : b * SEQ + 64 * (cidx - 4);
            const int cur = step & 1;
            const LAS bf16_t* QD = IMG0 + cur * IMG; const LAS bf16_t* KI = QD + 64 * 136; const LAS bf16_t* VS = KI + 64 * 136; const LAS float* DC = DC0 + cur * 128;
            if (step + 1 < 36) { GLA_STAGE(cur ^ 1); if (step + 2 < 36) GLA_LOAD(step + 2); }
            if (lat) {
                const int st = wave >> 1;
#pragma unroll
                for (int x = 0; x < 2; ++x) {
                    const int tt = 2 * (wave & 1) + x;
                    f32x4 c = (f32x4){0.f, 0.f, 0.f, 0.f};
                    if (st <= tt) {
#pragma unroll
                        for (int ks = 0; ks < 4; ++ks) {
                            const bf16x8 ak = *(const LAS bf16x8*)(KI + (16 * st + fr) * 136 + 32 * ks + 8 * fq), bq = *(const LAS bf16x8*)(QD + (16 * tt + fr) * 136 + 32 * ks + 8 * fq);
                            c = __builtin_amdgcn_mfma_f32_16x16x32_bf16(ak, bq, c, 0, 0, 0);
                        }
                        if (st == tt) {
#pragma unroll
                            for (int r = 0; r < 4; ++r) if (4 * fq + r > fr) c[r] = 0.f;
                        }
                    }
                    u32x2 w; w.x = cvt_pk_bf16(c[0], c[1]); w.y = cvt_pk_bf16(c[2], c[3]);
                    *(LAS u32x2*)(AL + (16 * tt + fr) * 72 + 16 * st + 4 * fq) = w;
                }
            }
            LDS_BARRIER();
            bf16x8 vf[2], aK[4][2], bA[2][2], bq[2][4]; f32x4 dc[4];
#pragma unroll
            for (int ks = 0; ks < 2; ++ks) {
                const s16x4 lo = lds_tr4(VS + (32 * ks + 8 * fq + (fr >> 2)) * 72 + 16 * et + 4 * (fr & 3)), hi = lds_tr4(VS + (32 * ks + 8 * fq + 4 + (fr >> 2)) * 72 + 16 * et + 4 * (fr & 3));
                vf[ks] = __builtin_shufflevector(lo, hi, 0, 1, 2, 3, 4, 5, 6, 7);
            }
            if (lat) {
#pragma unroll
                for (int x = 0; x < 2; ++x)
#pragma unroll
                    for (int ks = 0; ks < 2; ++ks) bA[x][ks] = *(const LAS bf16x8*)(AL + (16 * (2 * hf + x) + fr) * 72 + 32 * ks + 8 * fq);
#pragma unroll
                for (int kk = 0; kk < 2; ++kk)
#pragma unroll
                    for (int tt = 0; tt < 4; ++tt) {
                        const int k2 = 2 * hf + kk;
                        const s16x4 lo = *(const LAS s16x4*)(QD + (16 * tt + fr) * 136 + 32 * k2 + 4 * fq), hi = *(const LAS s16x4*)(QD + (16 * tt + fr) * 136 + 32 * k2 + 16 + 4 * fq);
                        bq[kk][tt] = __builtin_shufflevector(lo, hi, 0, 1, 2, 3, 4, 5, 6, 7);
                    }
            }
#pragma unroll
            for (int dl = 0; dl < 4; ++dl) {
                const int dt = 4 * hf + dl;
#pragma unroll
                for (int ks = 0; ks < 2; ++ks) {
                    const s16x4 lo = lds_tr4(KI + (32 * ks + 8 * fq + (fr >> 2)) * 136 + 16 * dt + 4 * (fr & 3)), hi = lds_tr4(KI + (32 * ks + 8 * fq + 4 + (fr >> 2)) * 136 + 16 * dt + 4 * (fr & 3));
                    aK[dl][ks] = __builtin_shufflevector(lo, hi, 0, 1, 2, 3, 4, 5, 6, 7);
                }
                dc[dl] = *(const LAS f32x4*)(DC + 16 * dt + 4 * fq);
            }
            __builtin_amdgcn_sched_barrier(0);
            f32x4 o[4];
            if (lat) {
#pragma unroll
                for (int tt = 0; tt < 4; ++tt) o[tt] = (f32x4){0.f, 0.f, 0.f, 0.f};
#pragma unroll
                for (int kk = 0; kk < 2; ++kk) {
                    u32x4 w; w.x = cvt_pk_bf16(S[2 * kk][0], S[2 * kk][1]); w.y = cvt_pk_bf16(S[2 * kk][2], S[2 * kk][3]); w.z = cvt_pk_bf16(S[2 * kk + 1][0], S[2 * kk + 1][1]); w.w = cvt_pk_bf16(S[2 * kk + 1][2], S[2 * kk + 1][3]);
                    const bf16x8 sa = __builtin_bit_cast(bf16x8, w);
#pragma unroll
                    for (int tt = 0; tt < 4; ++tt) o[tt] = __builtin_amdgcn_mfma_f32_16x16x32_bf16(sa, bq[kk][tt], o[tt], 0, 0, 0);
                }
#pragma unroll
                for (int x = 0; x < 2; ++x)
#pragma unroll
                    for (int ks = 0; ks < 2; ++ks) {
                        if (hf == 0) o[x] = __builtin_amdgcn_mfma_f32_16x16x32_bf16(vf[ks], bA[x][ks], o[x], 0, 0, 0); else o[2 + x] = __builtin_amdgcn_mfma_f32_16x16x32_bf16(vf[ks], bA[x][ks], o[2 + x], 0, 0, 0);
                    }
                LAS f32x4* ox = (LAS f32x4*)OX + (wave * 2) * 64 + lane;
                if (hf == 0) { ox[0] = o[2]; ox[64] = o[3]; } else { ox[0] = o[0]; ox[64] = o[1]; }
            }
#pragma unroll
            for (int ks = 0; ks < 2; ++ks)
#pragma unroll
                for (int dl = 0; dl < 4; ++dl) S[dl] = __builtin_amdgcn_mfma_f32_16x16x32_bf16(aK[dl][ks], vf[ks], S[dl], 0, 0, 0);
#pragma unroll
            for (int dl = 0; dl < 4; ++dl) S[dl] = S[dl] * dc[dl];
            LDS_BARRIER();
            if (lat) {
                const LAS f32x4* ox = (const LAS f32x4*)OX + ((wave ^ 4) * 2) * 64 + lane;
#pragma unroll
                for (int x = 0; x < 2; ++x) {
                    const f32x4 mine = hf == 0 ? o[x] : o[2 + x];
                    const f32x4 v = mine + ox[64 * x];
                    const int tp = 16 * (2 * hf + x) + fr; const size_t gr = (size_t)(row0 + (dir ? 63 - tp : tp));
                    u32x2 w; w.x = cvt_pk_bf16(v[0], v[1]); w.y = cvt_pk_bf16(v[2], v[3]);
                    *(u32x2*)(OUT + gr * D + 16 * et + 4 * fq) = w;
                }
            }
        }
#undef GLA_LOAD
#undef GLA_STAGE
    }
    __syncthreads();
}

__device__ __forceinline__ void gla_post_phase(const bf16_t* OFB, const bf16_t* QKVG, const float* hng, bf16_t* OG, int G) {
    const int lane = threadIdx.x & 63, wave = threadIdx.x >> 6;
    float hgv[16];
#pragma unroll
    for (int i = 0; i < 4; ++i) { const f32x4 t = *(const f32x4*)(hng + 16 * lane + 4 * i); hgv[4 * i] = t[0]; hgv[4 * i + 1] = t[1]; hgv[4 * i + 2] = t[2]; hgv[4 * i + 3] = t[3]; }
    for (int row = blockIdx.x * 8 + wave; row < ML; row += G * 8) {
        const int c = 16 * lane;
        const u32x4 f0 = *(const u32x4*)(OFB + (size_t)row * D + c), f1 = *(const u32x4*)(OFB + (size_t)row * D + c + 8);
        const u32x4 b0 = *(const u32x4*)(OFB + (size_t)ML * D + (size_t)row * D + c), b1 = *(const u32x4*)(OFB + (size_t)ML * D + (size_t)row * D + c + 8);
        const u32x4 g0 = *(const u32x4*)(QKVG + (size_t)row * N1 + 2048 + c), g1 = *(const u32x4*)(QKVG + (size_t)row * N1 + 2048 + c + 8);
        float o[16], g[16];
#pragma unroll
        for (int i = 0; i < 4; ++i) {
            o[2 * i] = bflo(f0[i]) + bflo(b0[i]); o[2 * i + 1] = bfhi(f0[i]) + bfhi(b0[i]);
            o[8 + 2 * i] = bflo(f1[i]) + bflo(b1[i]); o[8 + 2 * i + 1] = bfhi(f1[i]) + bfhi(b1[i]);
            g[2 * i] = bflo(g0[i]); g[2 * i + 1] = bfhi(g0[i]); g[8 + 2 * i] = bflo(g1[i]); g[8 + 2 * i + 1] = bfhi(g1[i]);
        }
        float ss = 0.f;
#pragma unroll
        for (int i = 0; i < 16; ++i) ss += o[i] * o[i];
        ss += __shfl_xor(ss, 1); ss += __shfl_xor(ss, 2); ss += __shfl_xor(ss, 4); ss += __shfl_xor(ss, 8);
        const float rstd = rsqrtf(ss * (1.f / 256.f) + EPS);
        unsigned w[8];
#pragma unroll
        for (int i = 0; i < 8; ++i) {
            const float y0 = o[2 * i] * rstd * hgv[2 * i] * silu_f(g[2 * i]), y1 = o[2 * i + 1] * rstd * hgv[2 * i + 1] * silu_f(g[2 * i + 1]);
            w[i] = cvt_pk_bf16(y0, y1);
        }
        *(u32x4*)(OG + (size_t)row * D + c) = (u32x4){w[0], w[1], w[2], w[3]};
        *(u32x4*)(OG + (size_t)row * D + c + 8) = (u32x4){w[4], w[5], w[6], w[7]};
    }
}

__device__ __forceinline__ void final_norm_phase(const bf16_t* X2, float* out, const float* g, int G) {
    const int lane = threadIdx.x & 63, wave = threadIdx.x >> 6;
    for (int row = blockIdx.x * 8 + wave; row < ML; row += G * 8) {
        const bf16_t* xr = X2 + (size_t)row * D; float* orow = out + (size_t)row * D;
        float x[16]; float ss = 0.f;
#pragma unroll
        for (int j = 0; j < 2; ++j) {
            const u32x4 u = *(const u32x4*)(xr + 8 * lane + 512 * j);
#pragma unroll
            for (int i = 0; i < 4; ++i) { x[8 * j + 2 * i] = bflo(u[i]); x[8 * j + 2 * i + 1] = bfhi(u[i]); }
        }
#pragma unroll
        for (int i = 0; i < 16; ++i) ss += x[i] * x[i];
        const float rstd = rsqrtf(wave_sum(ss) * (1.f / D) + EPS);
#pragma unroll
        for (int j = 0; j < 2; ++j)
#pragma unroll
            for (int i = 0; i < 2; ++i) {
                const int c = 8 * lane + 512 * j + 4 * i;
                const f32x4 xv = (f32x4){x[8 * j + 4 * i], x[8 * j + 4 * i + 1], x[8 * j + 4 * i + 2], x[8 * j + 4 * i + 3]};
                *(f32x4*)(orow + c) = (xv * rstd) * *(const f32x4*)(g + c);
            }
    }
}

#define XB_TMO      128
#define XB_XCNT(j)  (256  + 64 * (j))
#define XB_XSUB(j)  (1280 + 64 * (j))
#define XB_XGEN(j)  (2304 + 64 * (j))
#define XB_TOP      3328
#define XB_TOPGEN   3392
#define XCD_BAR_WORDS 3456
#define XB_SPIN_CAP (1u << 18)
__device__ __forceinline__ unsigned xb_ld(unsigned* p)              { return __hip_atomic_load(p, __ATOMIC_RELAXED, __HIP_MEMORY_SCOPE_AGENT); }
__device__ __forceinline__ unsigned xb_add(unsigned* p, unsigned v) { return __hip_atomic_fetch_add(p, v, __ATOMIC_RELAXED, __HIP_MEMORY_SCOPE_AGENT); }
__device__ __forceinline__ unsigned xb_xcc_id() { return (unsigned)__builtin_amdgcn_s_getreg((3 << 11) | 20) & 0xFu; }
#define XB_SPIN(cond, bar) do { unsigned _sp = 0; while (cond) { __builtin_amdgcn_s_sleep(1); \
    if ((++_sp & 255u) == 0u) { if (xb_ld(&(bar)[XB_TMO])) break; if (_sp > XB_SPIN_CAP) { atomicAdd(&(bar)[XB_TMO], 1u); break; } } } } while (0)
struct XcdBarrier { unsigned* bar; unsigned x; volatile LAS unsigned* st; };
__device__ __forceinline__ XcdBarrier xcd_barrier_post(unsigned* bar, volatile LAS unsigned* st) {
    XcdBarrier b; b.bar = bar; b.x = xb_xcc_id(); b.st = st;
    if (threadIdx.x == 0) (void)xb_add(&bar[XB_XCNT(b.x)], 1u);
    return b;
}
__device__ __forceinline__ void xcd_barrier_complete(unsigned* bar, unsigned x, unsigned& nloc, unsigned& nx) {
    const unsigned G = gridDim.x * gridDim.y * gridDim.z;
    unsigned sum, cnt, mine, sp = 0u;
    for (;;) {
        sum = 0u; cnt = 0u; mine = 0u;
#pragma unroll
        for (unsigned j = 0; j < 16; ++j) { const unsigned c = xb_ld(&bar[XB_XCNT(j)]); sum += c; cnt += (c > 0u) ? 1u : 0u; mine = (j == x) ? c : mine; }
        if (sum == G) break;
        __builtin_amdgcn_s_sleep(1);
        if ((++sp & 255u) == 0u) { if (xb_ld(&bar[XB_TMO])) break; if (sp > XB_SPIN_CAP) { atomicAdd(&bar[XB_TMO], 1u); break; } }
    }
    nloc = mine > 0u ? mine : 1u; nx = cnt > 0u ? cnt : 1u;
}
__device__ __forceinline__ void xcd_barrier(const XcdBarrier& b) {
    asm volatile("s_waitcnt vmcnt(0)" ::: "memory");
    __syncthreads();
    if (threadIdx.x == 0) {
        unsigned* bar = b.bar;
        __builtin_amdgcn_s_waitcnt(0);
        unsigned nloc = b.st[0], nx = b.st[1];
        if (nloc == 0u) { xcd_barrier_complete(bar, b.x, nloc, nx); b.st[0] = nloc; b.st[1] = nx; }
        const unsigned old = xb_add(&bar[XB_XSUB(b.x)], 1u);
        const unsigned gen = old / nloc;
        if (old + 1u == (gen + 1u) * nloc) {
            __builtin_amdgcn_fence(__ATOMIC_RELEASE, "agent");
            asm volatile("s_waitcnt vmcnt(0)" ::: "memory");
            const unsigned og = xb_add(&bar[XB_TOP], 1u);
            const unsigned tg = og / nx;
            if (og + 1u == (tg + 1u) * nx) xb_add(&bar[XB_TOPGEN], 1u);
            else XB_SPIN(xb_ld(&bar[XB_TOPGEN]) == tg, bar);
            __builtin_amdgcn_fence(__ATOMIC_ACQUIRE, "agent");
            xb_add(&bar[XB_XGEN(b.x)], 1u);
            asm volatile("s_waitcnt vmcnt(0)" ::: "memory");
        } else {
            XB_SPIN(xb_ld(&bar[XB_XGEN(b.x)]) == gen, bar);
            __builtin_amdgcn_fence(__ATOMIC_ACQUIRE, "agent");
            asm volatile("s_waitcnt vmcnt(0)" ::: "memory");
        }
    }
    __syncthreads();
}

__global__ void __launch_bounds__(512, 2) fwd_megakernel(Args args) {
    extern __shared__ __attribute__((aligned(16))) unsigned char lds_raw[];
    LAS unsigned char* lds = (LAS unsigned char*)lds_raw;
    if (threadIdx.x < 2) ((LAS unsigned*)(lds + LDS_MISC_OFF))[threadIdx.x] = 0u;
    __syncthreads();
    const XcdBarrier xbar = xcd_barrier_post((unsigned*)(args.ws + WS_CTL), (volatile LAS unsigned*)(lds + LDS_MISC_OFF));
    const int G = gridDim.x;
    unsigned char* ws = args.ws;
    const int lo = args.ph_lo, hi = args.ph_hi;
#ifndef PH_MASK
#define PH_MASK 0xfff
#endif
#define IN(k) (((PH_MASK >> (k)) & 1) && lo <= (k) && (k) < hi)
#define SEAM(k) do { if (IN(k) && IN((k) + 1)) xcd_barrier(xbar); } while (0)
#ifndef DUP_MASK
#define DUP_MASK 0x000
#endif
#define REP(k) for (int rep_ = 0; rep_ <= ((DUP_MASK >> (k)) & 1); ++rep_) if (rep_ == 0 || (xcd_barrier(xbar), true))
    bf16_t* WT0 = (bf16_t*)(ws + WS_WT0); bf16_t* WO0 = (bf16_t*)(ws + WS_WO0); bf16_t* WT1 = (bf16_t*)(ws + WS_WT1); bf16_t* WO1 = (bf16_t*)(ws + WS_WO1);
    float* MOD0 = (float*)(ws + WS_MOD0); float* MOD1 = (float*)(ws + WS_MOD1);
    float* cosT = (float*)(ws + WS_ROPE); float* sinT = cosT + 1024;
    float* R = (float*)(ws + WS_R); bf16_t* X1 = (bf16_t*)(ws + WS_X1); float* DEC = (float*)(ws + WS_DEC);
    bf16_t* QKVG = (bf16_t*)(ws + WS_A); bf16_t* HB = (bf16_t*)(ws + WS_B);
    bf16_t* OUTB = (bf16_t*)args.out;

    if (IN(0)) REP(0) { p0_prologue(args, lds, (int)blockIdx.x, G, 0); }
    if (IN(1)) REP(1) { norm_mod_wait_phase(args.in[I_X], args.in[I_CTX], args.in[I_L0_NG], MOD0, HB, G); } SEAM(1);
    if (IN(2)) REP(2) {
        pg8::Gemm g{HB, WT0, MT, N0, D}; pg8::Sched S; S.init(MT, N0, G, (int)blockIdx.x, 0);
        pg8::EpiQKVG0 E{QKVG, cosT, sinT};
        pg8::gemm_phase<pg8::EpiQKVG0, pg8::Sched, true, true>(lds, g, S, E);
        { const int r = ((MT / 256) * (N0 / 256)) % G, first = r, nidle = G - r;
          if ((int)blockIdx.x >= first) { __syncthreads(); p0_prologue(args, lds, (int)blockIdx.x - first, nidle, 1); } }
    } SEAM(2);
    if (IN(3)) REP(3) { attn_phase(QKVG, args.in[I_L0_SINK], OUTB, lds, G); } SEAM(3);
    const bool fuse_pn = (G == 256) && lo == 0 && hi == NPHASE;
    if (IN(4)) REP(4) {
        pg8::Gemm g{OUTB, WO0, MT, D, D};
        if (fuse_pn) {
            pg8::SchedPanel S{G, (int)blockIdx.x};
            pg8::EpiRes0Norm E{args.in[I_X], args.in[I_CTX], MOD0, MOD1, args.in[I_L1_NG], X1, HB, (unsigned long long*)(ws + WS_SS4)};
            pg8::gemm_phase<pg8::EpiRes0Norm, pg8::SchedPanel, true, true>(lds, g, S, E);
        } else {
            pg8::Sched S; S.init(MT, D, G, (int)blockIdx.x, 0);
            pg8::EpiRes0 E{args.in[I_X], args.in[I_CTX], MOD0, X1};
            pg8::gemm_phase<pg8::EpiRes0, pg8::Sched, true, true>(lds, g, S, E);
        }
    } SEAM(4);
    if (!fuse_pn) { if (IN(5)) REP(5) { norm_mod_bf16_phase(X1, args.in[I_L1_NG], MOD1, HB, G); } SEAM(5); }
    if (IN(6)) REP(6) {
        pg8::Gemm g{HB, WT1, ML, N1P, D}; pg8::Sched S; S.init(ML, N1P, G, (int)blockIdx.x, 56);
        pg8::EpiQKVG1 E{QKVG, R};
        pg8::gemm_phase<pg8::EpiQKVG1, pg8::Sched, true, true>(lds, g, S, E);
    } SEAM(6);
    if (IN(7)) REP(7) { gla_prep_phase(args, QKVG, R, HB, HB + (size_t)ML * 512, DEC, lds, G); } SEAM(7);
    if (IN(8)) REP(8) { gla_phase(QKVG, HB, HB + (size_t)ML * 512, DEC, OUTB, lds, G); } SEAM(8);
    if (IN(9)) REP(9) { gla_post_phase(OUTB, QKVG, args.in[I_L1_HNG], HB, G); } SEAM(9);
    const bool fuse_fn = (G == 256) && lo == 0 && hi == NPHASE;
    if (IN(10)) REP(10) {
        pg8::Gemm g{HB, WO1, ML, D, D}; pg8::Sched S; S.init(ML, D, G, (int)blockIdx.x, 0);
        if (fuse_fn) {
            pg8::EpiResNorm E{X1, MOD1, args.in[I_FNG], args.out, (unsigned long long*)(ws + WS_SS)};
            pg8::gemm_phase<pg8::EpiResNorm, pg8::Sched, true, true>(lds, g, S, E);
        } else {
            pg8::EpiRes1 E{X1, MOD1, QKVG};
            pg8::gemm_phase<pg8::EpiRes1, pg8::Sched, true, true>(lds, g, S, E);
        }
    }
    if (!fuse_fn) { SEAM(10); if (IN(11)) REP(11) { final_norm_phase(QKVG, args.out, args.in[I_FNG], G); } }
#undef IN
#undef SEAM
}

extern "C" void kernel_launch(void* const* d_in, const int* in_sizes, int n_in, void* d_out, int out_size, void* d_ws, size_t ws_size, hipStream_t stream) {
    static int grid = 0;
    if (grid == 0) {
        int dev = 0, cus = 0, per_cu = 0;
        if (n_in != 23 || ws_size < WS_END) { fprintf(stderr, "kernel_launch: unexpected inputs (n_in %d, ws %zu)\n", n_in, ws_size); grid = -1; return; }
        (void)hipGetDevice(&dev);
        (void)hipDeviceGetAttribute(&cus, hipDeviceAttributeMultiprocessorCount, dev);
        if (hipFuncSetAttribute((const void*)fwd_megakernel, hipFuncAttributeMaxDynamicSharedMemorySize, LDS_BYTES) != hipSuccess) { fprintf(stderr, "kernel_launch: hipFuncSetAttribute failed\n"); grid = -1; return; }
        if (hipOccupancyMaxActiveBlocksPerMultiprocessor(&per_cu, (const void*)fwd_megakernel, 512, LDS_BYTES) != hipSuccess || per_cu < 1) { fprintf(stderr, "kernel_launch: occupancy query says %d blocks per CU\n", per_cu); per_cu = 1; }
        (void)hipGetLastError();
        grid = cus;
    }
    if (grid < 0) return;
    if (hipMemsetAsync((char*)d_ws + WS_CTL, 0, CTL_BYTES, stream) != hipSuccess) { fprintf(stderr, "kernel_launch: memset failed\n"); return; }
    Args a{};
    for (int i = 0; i < 23; ++i) a.in[i] = (const float*)d_in[i];
    a.out = (float*)d_out; a.ws = (unsigned char*)d_ws;
#if MK_N_LAUNCHES == 1
    a.ph_lo = 0; a.ph_hi = NPHASE;
    void* kargs[] = {&a};
    hipError_t e = hipLaunchCooperativeKernel((const void*)fwd_megakernel, dim3(grid), dim3(512), kargs, LDS_BYTES, stream);
    if (e != hipSuccess) fprintf(stderr, "cooperative launch failed: %s (grid %d)\n", hipGetErrorString(e), grid);
#else
    for (int p = 0; p < NPHASE; ++p) {
        a.ph_lo = p; a.ph_hi = p + 1;
        hipLaunchKernelGGL(fwd_megakernel, dim3(grid), dim3(512), LDS_BYTES, stream, a);
    }
#endif
}
```

```cpp
#include <hip/hip_runtime.h>
#include <hip/hip_cooperative_groups.h>
#include <cstdio>
#include <cstdint>
namespace cg = cooperative_groups;

#define LAS __attribute__((address_space(3)))
#define GAS __attribute__((address_space(1)))
typedef unsigned short bf16_t;
typedef short bf16x8 __attribute__((ext_vector_type(8)));
typedef short s16x4 __attribute__((ext_vector_type(4)));
typedef float f32x4 __attribute__((ext_vector_type(4)));
typedef unsigned u32x4 __attribute__((ext_vector_type(4)));
typedef unsigned u32x2 __attribute__((ext_vector_type(2)));

#ifndef MK_N_LAUNCHES
#define MK_N_LAUNCHES 1
#endif

constexpr int D = 1024, NBATCH = 8, SEQ = 2048, CTXL = 256;
constexpr int ML = NBATCH * SEQ;
constexpr int MC = NBATCH * CTXL;
constexpr int MT = ML + MC;
constexpr int N0 = 2304;
constexpr int N1 = 3072;
constexpr int N1P = 3328;
constexpr float EPS = 1e-6f;
constexpr int NPHASE = 12;

constexpr size_t WS_WT0 = 0;
constexpr size_t WS_WO0 = WS_WT0 + (size_t)N0 * D * 2;
constexpr size_t WS_WT1 = WS_WO0 + (size_t)D * D * 2;
constexpr size_t WS_WO1 = WS_WT1 + (size_t)N1P * D * 2;
constexpr size_t WS_MOD1 = WS_WO1 + (size_t)D * D * 2;
constexpr size_t WS_ROPE = WS_MOD1 + 9 * 3072 * 4;
constexpr size_t WS_R = WS_ROPE + 2 * 64 * 16 * 4;
constexpr size_t WS_DEC = WS_R + (size_t)MT * 32 * 4;
constexpr size_t WS_X1 = WS_DEC + (size_t)2 * 8 * 4 * 36 * 128 * 4;
constexpr size_t WS_A = WS_X1 + (size_t)MT * D * 2;
constexpr size_t WS_B = WS_A + (size_t)MT * N1 * 2;
constexpr size_t WS_CTL = WS_B + (size_t)MT * D * 2;
constexpr size_t CTL_BYTES = 32768 + (size_t)ML * 8 + 9 * 3072 * 4 + (size_t)MT * 8;
constexpr size_t WS_SS = WS_CTL + 32768;
constexpr size_t WS_MOD0 = WS_SS + (size_t)ML * 8;
constexpr size_t WS_SS4 = WS_MOD0 + 9 * 3072 * 4;
constexpr size_t WS_END = WS_CTL + CTL_BYTES;
static_assert(WS_END <= 268435456, "d_ws map");

constexpr int LDS_BYTES = 147456;
constexpr int LDS_MISC_OFF = LDS_BYTES - 64;

typedef __bf16 bf16x2_t __attribute__((ext_vector_type(2)));
typedef float f32x2_t __attribute__((ext_vector_type(2)));
__device__ __forceinline__ unsigned cvt_pk_bf16(float lo, float hi) { f32x2_t v = {lo, hi}; bf16x2_t r = __builtin_convertvector(v, bf16x2_t); return __builtin_bit_cast(unsigned, r); }
__device__ __forceinline__ float bf2f(bf16_t u) { return __builtin_bit_cast(float, (unsigned)u << 16); }
__device__ __forceinline__ float bflo(unsigned u) { return __builtin_bit_cast(float, u << 16); }
__device__ __forceinline__ float bfhi(unsigned u) { return __builtin_bit_cast(float, u & 0xffff0000u); }
__device__ __forceinline__ bf16_t f2bf(float f) { return (bf16_t)(cvt_pk_bf16(f, 0.f) & 0xffffu); }
__device__ __forceinline__ float silu_f(float x) { return x * __builtin_amdgcn_rcpf(1.f + __expf(-x)); }
#define LDS_BARRIER() do { asm volatile("s_waitcnt lgkmcnt(0)" ::: "memory"); __builtin_amdgcn_s_barrier(); asm volatile("" ::: "memory"); } while (0)
__device__ __forceinline__ s16x4 lds_tr4(const LAS bf16_t* p) { return __builtin_amdgcn_ds_read_tr16_b64_v4i16((LAS s16x4*)p); }
__device__ __forceinline__ float wave_sum(float v) {
#pragma unroll
    for (int o = 1; o < 64; o <<= 1) v += __shfl_xor(v, o);
    return v;
}

namespace pg8 {
constexpr int BM = 256, BK = 64, HALF = 128, HTB = HALF * BK * 2, STAGE_BYTES = 8 * HTB, NXCD = 8, WGM = 8;
__host__ __device__ __forceinline__ int lds_byte(int r, int c) { const int st = (r >> 4) * 2 + (c >> 5), rr = r & 15, cc = c & 31, ob = rr * 64 + cc * 2; return st * 1024 + (ob ^ (((ob >> 9) & 1) << 5)); }
__host__ __device__ __forceinline__ void stage_rc(int b, int& R, int& C) { const int st = b / 1024, sb = b % 1024, swz = sb ^ (((sb >> 9) & 1) << 5); R = (st >> 1) * 16 + swz / 64; C = (st & 1) * 32 + (swz % 64) / 2; }
__host__ __device__ __forceinline__ int perm32(int rho) { const int n = rho >> 4, i = rho & 15; return 8 * (i >> 2) + 4 * n + (i & 3); }

struct Unit { int pm, pn; };
struct Gemm { const bf16_t* A; const bf16_t* Bt; int M, N, K; };

struct Sched {
    int nM, nN, nwg, G, c, nx;
    __device__ void init(int M, int N, int G_, int c_, int nx_) { nM = M / BM; nN = N / BM; nwg = nM * nN; G = G_; c = c_; nx = nx_; }
    __device__ bool next(int i, Unit& u) const {
        const long L = (long)i * G + c; if (L >= nwg + nx) return false;
        if (L >= nwg) { const int e = (int)L - nwg; u.pm = 64 + e / 7; const int j = e % 7; u.pn = j < 6 ? 2 + j : 12; return true; }
        int wgid = (int)L; { const int q = nwg / NXCD, r = nwg % NXCD, xcd = wgid % NXCD, off = wgid / NXCD; wgid = (xcd < r ? xcd * (q + 1) : r * (q + 1) + (xcd - r) * q) + off; }
        const int nig = WGM * nN, gid = wgid / nig, fm = gid * WGM, gsz = (nM - fm) < WGM ? (nM - fm) : WGM;
        u.pm = fm + ((wgid % nig) % gsz); u.pn = (wgid % nig) / gsz; return true;
    }
    __device__ __forceinline__ void a_ready(const Unit&) const {}
    __device__ __forceinline__ void done(const Unit&) const {}
};


struct EpiQKVG0 {
    static constexpr bool PERM = true, AFTER_DRAIN = false, XCHG = false;
    bf16_t* O; const float* cosT; const float* sinT;
    __device__ __forceinline__ void operator()(const f32x4 (&acc)[2][2][4][2], const Unit& u, int wr, int wc, int fr, int fq) const {
        const int pn = u.pn; const bool latent = u.pm < 64;
        const float sc = (pn < 4) ? 0.125f * 1.4426950408889634f : 1.f;
        const bool rope0 = latent && pn <= 4, rope1 = latent && pn < 4;
#pragma unroll
        for (int ai = 0; ai < 2; ++ai)
#pragma unroll
            for (int mp = 0; mp < 2; ++mp) {
                f32x4 tc[2][2], ts[2][2];
                if (rope0) {
#pragma unroll
                    for (int mm = 0; mm < 2; ++mm) {
                        const int tok = (u.pm * BM + ai * HALF + wr * 64 + (2 * mp + mm) * 16 + fr) & (SEQ - 1);
                        const int to = ((wc & 1) ? (tok & 63) : (tok >> 6)) * 16 + 8 * (fq & 1);
                        tc[mm][0] = *(const f32x4*)(cosT + to); tc[mm][1] = *(const f32x4*)(cosT + to + 4); ts[mm][0] = *(const f32x4*)(sinT + to); ts[mm][1] = *(const f32x4*)(sinT + to + 4);
                    }
                }
#pragma unroll
                for (int mm = 0; mm < 2; ++mm) {
                    const int m = 2 * mp + mm;
                    const int row = u.pm * BM + ai * HALF + wr * 64 + m * 16 + fr;
#pragma unroll
                    for (int bj = 0; bj < 2; ++bj) {
                        const int col = pn * BM + bj * HALF + wc * 32 + 8 * fq;
                        f32x4 v0 = acc[ai][bj][m][0], v1 = acc[ai][bj][m][1];
                        if (bj == 0 ? rope0 : rope1) {
                            f32x4 p0, p1;
#pragma unroll
                            for (int i = 0; i < 4; ++i) { p0[i] = __shfl_xor(v0[i], 32); p1[i] = __shfl_xor(v1[i], 32); }
                            if (fq < 2) { v0 = v0 * tc[mm][0] - p0 * ts[mm][0]; v1 = v1 * tc[mm][1] - p1 * ts[mm][1]; }
                            else        { v0 = p0 * ts[mm][0] + v0 * tc[mm][0]; v1 = p1 * ts[mm][1] + v1 * tc[mm][1]; }
                        }
                        v0 = v0 * sc; v1 = v1 * sc;
                        u32x4 w; w.x = cvt_pk_bf16(v0[0], v0[1]); w.y = cvt_pk_bf16(v0[2], v0[3]); w.z = cvt_pk_bf16(v1[0], v1[1]); w.w = cvt_pk_bf16(v1[2], v1[3]);
                        *(u32x4*)(O + (size_t)row * N0 + col) = w;
                    }
                }
            }
    }
};

struct EpiRes0 {
    static constexpr bool PERM = true, AFTER_DRAIN = false, XCHG = false;
    const float* res_lat; const float* res_ctx; const float* mod; bf16_t* out;
    __device__ __forceinline__ void operator()(const f32x4 (&acc)[2][2][4][2], const Unit& u, int wr, int wc, int fr, int fq) const {
#pragma unroll
        for (int ai = 0; ai < 2; ++ai)
#pragma unroll
            for (int m = 0; m < 4; ++m) {
                const int row = u.pm * BM + ai * HALF + wr * 64 + m * 16 + fr;
                const int v = row < ML ? (row >> 11) : 8;
                const float* rr = row < ML ? res_lat + (size_t)row * D : res_ctx + (size_t)(row - ML) * D;
                const float* gg = mod + v * 3072 + 2048;
                bf16_t* oo = out + (size_t)row * D;
#pragma unroll
                for (int bj = 0; bj < 2; ++bj) {
                    const int col = u.pn * BM + bj * HALF + wc * 32 + 8 * fq;
                    const f32x4 r0 = *(const f32x4*)(rr + col), r1 = *(const f32x4*)(rr + col + 4), g0 = *(const f32x4*)(gg + col), g1 = *(const f32x4*)(gg + col + 4);
                    const f32x4 v0 = r0 + g0 * acc[ai][bj][m][0], v1 = r1 + g1 * acc[ai][bj][m][1];
                    u32x4 w; w.x = cvt_pk_bf16(v0[0], v0[1]); w.y = cvt_pk_bf16(v0[2], v0[3]); w.z = cvt_pk_bf16(v1[0], v1[1]); w.w = cvt_pk_bf16(v1[2], v1[3]);
                    *(u32x4*)(oo + col) = w;
                }
            }
    }
};
struct EpiRes1 {
    static constexpr bool PERM = true, AFTER_DRAIN = false, XCHG = false;
    const bf16_t* res; const float* mod; bf16_t* out;
    __device__ __forceinline__ void operator()(const f32x4 (&acc)[2][2][4][2], const Unit& u, int wr, int wc, int fr, int fq) const {
#pragma unroll
        for (int ai = 0; ai < 2; ++ai)
#pragma unroll
            for (int m = 0; m < 4; ++m) {
                const int row = u.pm * BM + ai * HALF + wr * 64 + m * 16 + fr;
                const bf16_t* rr = res + (size_t)row * D; const float* gg = mod + (row >> 11) * 3072 + 2048;
                bf16_t* oo = out + (size_t)row * D;
#pragma unroll
                for (int bj = 0; bj < 2; ++bj) {
                    const int col = u.pn * BM + bj * HALF + wc * 32 + 8 * fq;
                    const u32x4 rb = *(const u32x4*)(rr + col);
                    const f32x4 r0 = (f32x4){bflo(rb.x), bfhi(rb.x), bflo(rb.y), bfhi(rb.y)}, r1 = (f32x4){bflo(rb.z), bfhi(rb.z), bflo(rb.w), bfhi(rb.w)};
                    const f32x4 g0 = *(const f32x4*)(gg + col), g1 = *(const f32x4*)(gg + col + 4);
                    const f32x4 v0 = r0 + g0 * acc[ai][bj][m][0], v1 = r1 + g1 * acc[ai][bj][m][1];
                    u32x4 w; w.x = cvt_pk_bf16(v0[0], v0[1]); w.y = cvt_pk_bf16(v0[2], v0[3]); w.z = cvt_pk_bf16(v1[0], v1[1]); w.w = cvt_pk_bf16(v1[2], v1[3]);
                    *(u32x4*)(oo + col) = w;
                }
            }
    }
};

struct EpiQKVG1 {
    static constexpr bool PERM = true, AFTER_DRAIN = false, XCHG = false;
    bf16_t* O; float* R;
    __device__ __forceinline__ void operator()(const f32x4 (&acc)[2][2][4][2], const Unit& u, int wr, int wc, int fr, int fq) const {
        const int pn = u.pn;
        if (pn == 12) {
            if (wc == 0) {
#pragma unroll
                for (int ai = 0; ai < 2; ++ai)
#pragma unroll
                    for (int m = 0; m < 4; ++m) {
                        const int row = u.pm * BM + ai * HALF + wr * 64 + m * 16 + fr;
                        *(f32x4*)(R + (size_t)row * 32 + 8 * fq) = acc[ai][0][m][0];
                        *(f32x4*)(R + (size_t)row * 32 + 8 * fq + 4) = acc[ai][0][m][1];
                    }
            }
            return;
        }
        const float sc = (pn < 2) ? 0.08838834764831845f : 1.f;
#pragma unroll
        for (int ai = 0; ai < 2; ++ai)
#pragma unroll
            for (int m = 0; m < 4; ++m) {
                const int row = u.pm * BM + ai * HALF + wr * 64 + m * 16 + fr;
#pragma unroll
                for (int bj = 0; bj < 2; ++bj) {
                    const int col = pn * BM + bj * HALF + wc * 32 + 8 * fq;
                    const f32x4 v0 = acc[ai][bj][m][0] * sc, v1 = acc[ai][bj][m][1] * sc;
                    u32x4 w; w.x = cvt_pk_bf16(v0[0], v0[1]); w.y = cvt_pk_bf16(v0[2], v0[3]); w.z = cvt_pk_bf16(v1[0], v1[1]); w.w = cvt_pk_bf16(v1[2], v1[3]);
                    *(u32x4*)(O + (size_t)row * N1 + col) = w;
                }
            }
    }
};

struct SchedPanel {
    int G, c;
    __device__ bool next(int i, Unit& u) const { const int L = i * G + c; if (L >= 288) return false; const int x = L & 7, j = L >> 3; u.pm = x + 8 * (j >> 2); u.pn = j & 3; return true; }
    __device__ __forceinline__ void a_ready(const Unit&) const {}
    __device__ __forceinline__ void done(const Unit&) const {}
};
struct EpiRes0Norm {
    static constexpr bool PERM = true, AFTER_DRAIN = false, XCHG = true;
    const float* res_lat; const float* res_ctx; const float* mod0; const float* mod1; const float* ng1; bf16_t* x1; bf16_t* h1; unsigned long long* ss;
    __device__ __forceinline__ void xchg(f32x4 (&acc)[2][2][4][2], const Unit& u, int wr, int wc, int fr, int fq, LAS unsigned char* scratch) const {
        LAS float* P = (LAS float*)scratch;
        LAS float* RS = P + 1024;
        const int tid = threadIdx.x;
        const int pmu = __builtin_amdgcn_readfirstlane(u.pm), pnu = __builtin_amdgcn_readfirstlane(u.pn), v = pmu < 64 ? (pmu >> 3) : 8;
        const float* rbase = pmu < 64 ? res_lat + (size_t)pmu * BM * D : res_ctx + (size_t)(pmu - 64) * BM * D;
        const int col0 = pnu * BM + wc * 32 + 8 * fq;
        const unsigned lofs = (unsigned)(fr * D + col0) * 2u;
        {
            f32x4 gt[2][2];
#pragma unroll
            for (int bj = 0; bj < 2; ++bj)
#pragma unroll
                for (int n = 0; n < 2; ++n) gt[bj][n] = *(const f32x4*)(mod0 + v * 3072 + 2048 + col0 + bj * HALF + 4 * n);
#pragma unroll
            for (int ai = 0; ai < 2; ++ai)
#pragma unroll
                for (int mp = 0; mp < 2; ++mp) {
                    f32x4 rres[2][2][2];
#pragma unroll
                    for (int mm = 0; mm < 2; ++mm) {
                        const int m = 2 * mp + mm;
                        const float* rr = (const float*)((const char*)(rbase + (size_t)(ai * HALF + wr * 64 + m * 16) * D) + 2u * lofs);
#pragma unroll
                        for (int bj = 0; bj < 2; ++bj) { rres[mm][bj][0] = *(const f32x4*)(rr + bj * HALF); rres[mm][bj][1] = *(const f32x4*)(rr + bj * HALF + 4); }
                    }
#pragma unroll
                    for (int mm = 0; mm < 2; ++mm) {
                        const int m = 2 * mp + mm;
                        const int rl = ai * HALF + wr * 64 + m * 16 + fr;
                        bf16_t* oo = (bf16_t*)((char*)(x1 + ((size_t)pmu * BM + ai * HALF + wr * 64 + m * 16) * D) + lofs);
                        float s2 = 0.f;
#pragma unroll
                        for (int bj = 0; bj < 2; ++bj) {
                            const f32x4 v0 = rres[mm][bj][0] + gt[bj][0] * acc[ai][bj][m][0], v1 = rres[mm][bj][1] + gt[bj][1] * acc[ai][bj][m][1];
                            acc[ai][bj][m][0] = v0; acc[ai][bj][m][1] = v1;
                            s2 += ((v0[0] * v0[0] + v0[1] * v0[1]) + (v0[2] * v0[2] + v0[3] * v0[3])) + ((v1[0] * v1[0] + v1[1] * v1[1]) + (v1[2] * v1[2] + v1[3] * v1[3]));
                            u32x4 w; w.x = cvt_pk_bf16(v0[0], v0[1]); w.y = cvt_pk_bf16(v0[2], v0[3]); w.z = cvt_pk_bf16(v1[0], v1[1]); w.w = cvt_pk_bf16(v1[2], v1[3]);
                            *(u32x4*)(oo + bj * HALF) = w;
                        }
                        s2 += __shfl_xor(s2, 16); s2 += __shfl_xor(s2, 32);
                        if (fq == 0) P[rl * 4 + wc] = s2;
                    }
                    __builtin_amdgcn_sched_barrier(0);
                }
        }
        __syncthreads();
        if (tid < 256) {
            const f32x4 p = *(const LAS f32x4*)(P + tid * 4);
            const float tot = (p[0] + p[1]) + (p[2] + p[3]);
            unsigned long long* a = ss + ((size_t)pmu * BM + tid);
            const unsigned long long mine = (1ull << 56) | (unsigned long long)(tot * 1048576.f + 0.5f);
            (void)__hip_atomic_fetch_add(a, mine, __ATOMIC_RELAXED, __HIP_MEMORY_SCOPE_AGENT);
            unsigned long long vv = __hip_atomic_load(a, __ATOMIC_RELAXED, __HIP_MEMORY_SCOPE_AGENT); unsigned sp = 0;
            while ((vv >> 56) < 4ull) { __builtin_amdgcn_s_sleep(1); vv = __hip_atomic_load(a, __ATOMIC_RELAXED, __HIP_MEMORY_SCOPE_AGENT); if (++sp > (1u << 22)) break; }
            const float sum = (float)(vv & ((1ull << 56) - 1ull)) * (1.f / 1048576.f);
            RS[tid] = rsqrtf(sum * (1.f / D) + EPS);
        }
        __syncthreads();
        {
            f32x4 gm[2][2], sh[2][2];
#pragma unroll
            for (int bj = 0; bj < 2; ++bj)
#pragma unroll
                for (int n = 0; n < 2; ++n) {
                    const int c = col0 + bj * HALF + 4 * n;
                    gm[bj][n] = *(const f32x4*)(ng1 + c) * (*(const f32x4*)(mod1 + v * 3072 + 1024 + c) + 1.f); sh[bj][n] = *(const f32x4*)(mod1 + v * 3072 + c);
                }
#pragma unroll
            for (int ai = 0; ai < 2; ++ai)
#pragma unroll
                for (int m = 0; m < 4; ++m) {
                    const int rl = ai * HALF + wr * 64 + m * 16 + fr;
                    const float rstd = RS[rl]; bf16_t* hh = (bf16_t*)((char*)(h1 + ((size_t)pmu * BM + ai * HALF + wr * 64 + m * 16) * D) + lofs);
#pragma unroll
                    for (int bj = 0; bj < 2; ++bj) {
                        const f32x4 y0 = (acc[ai][bj][m][0] * rstd) * gm[bj][0] + sh[bj][0], y1 = (acc[ai][bj][m][1] * rstd) * gm[bj][1] + sh[bj][1];
                        u32x4 w; w.x = cvt_pk_bf16(y0[0], y0[1]); w.y = cvt_pk_bf16(y0[2], y0[3]); w.z = cvt_pk_bf16(y1[0], y1[1]); w.w = cvt_pk_bf16(y1[2], y1[3]);
                        *(u32x4*)(hh + bj * HALF) = w;
                    }
                }
        }
        __syncthreads();
    }
};

struct EpiResNorm {
    static constexpr bool PERM = true, AFTER_DRAIN = true, XCHG = false;
    const bf16_t* res; const float* mod; const float* fg; float* out; unsigned long long* ss;
    __device__ __forceinline__ void fused(f32x4 (&acc)[2][2][4][2], const Unit& u, int wr, int wc, int fr, int fq, LAS unsigned char* lds, int wid, int lane) const {
        LAS float* P = (LAS float*)lds;
        LAS float* RS = P + 1024;
        const int tid = threadIdx.x;
#pragma unroll
        for (int ai = 0; ai < 2; ++ai)
#pragma unroll
            for (int m = 0; m < 4; ++m) {
                const int rl = ai * HALF + wr * 64 + m * 16 + fr; const int row = u.pm * BM + rl;
                const bf16_t* rr = res + (size_t)row * D; const float* gg = mod + (row >> 11) * 3072 + 2048;
                float s2 = 0.f;
#pragma unroll
                for (int bj = 0; bj < 2; ++bj) {
                    const int col = u.pn * BM + bj * HALF + wc * 32 + 8 * fq;
                    const u32x4 rb = *(const u32x4*)(rr + col);
                    const f32x4 r0 = (f32x4){bflo(rb.x), bfhi(rb.x), bflo(rb.y), bfhi(rb.y)}, r1 = (f32x4){bflo(rb.z), bfhi(rb.z), bflo(rb.w), bfhi(rb.w)};
                    const f32x4 g0 = *(const f32x4*)(gg + col), g1 = *(const f32x4*)(gg + col + 4);
                    const f32x4 v0 = r0 + g0 * acc[ai][bj][m][0], v1 = r1 + g1 * acc[ai][bj][m][1];
                    acc[ai][bj][m][0] = v0; acc[ai][bj][m][1] = v1;
                    s2 += ((v0[0] * v0[0] + v0[1] * v0[1]) + (v0[2] * v0[2] + v0[3] * v0[3])) + ((v1[0] * v1[0] + v1[1] * v1[1]) + (v1[2] * v1[2] + v1[3] * v1[3]));
                }
                s2 += __shfl_xor(s2, 16); s2 += __shfl_xor(s2, 32);
                if (fq == 0) P[rl * 4 + wc] = s2;
            }
        __syncthreads();
        if (tid < 256) {
            const f32x4 p = *(const LAS f32x4*)(P + tid * 4);
            const float tot = (p[0] + p[1]) + (p[2] + p[3]);
            unsigned long long* a = ss + (size_t)(u.pm * BM + tid);
            const unsigned long long mine = (1ull << 56) | (unsigned long long)(tot * 1048576.f + 0.5f);
            (void)__hip_atomic_fetch_add(a, mine, __ATOMIC_RELAXED, __HIP_MEMORY_SCOPE_AGENT);
            unsigned long long v = __hip_atomic_load(a, __ATOMIC_RELAXED, __HIP_MEMORY_SCOPE_AGENT); unsigned sp = 0;
            while ((v >> 56) < 4ull) { __builtin_amdgcn_s_sleep(1); v = __hip_atomic_load(a, __ATOMIC_RELAXED, __HIP_MEMORY_SCOPE_AGENT); if (++sp > (1u << 22)) break; }
            const float sum = (float)(v & ((1ull << 56) - 1ull)) * (1.f / 1048576.f);
            RS[tid] = rsqrtf(sum * (1.f / D) + EPS);
        }
        __syncthreads();
        f32x4 fgv[2][2];
#pragma unroll
        for (int bj = 0; bj < 2; ++bj)
#pragma unroll
            for (int n = 0; n < 2; ++n) fgv[bj][n] = *(const f32x4*)(fg + u.pn * BM + bj * HALF + wc * 32 + 8 * fq + 4 * n);
#pragma unroll
        for (int ai = 0; ai < 2; ++ai)
#pragma unroll
            for (int m = 0; m < 4; ++m) {
                const int rl = ai * HALF + wr * 64 + m * 16 + fr; const int row = u.pm * BM + rl;
                const float rstd = RS[rl]; float* oo = out + (size_t)row * D;
#pragma unroll
                for (int bj = 0; bj < 2; ++bj) {
                    const int col = u.pn * BM + bj * HALF + wc * 32 + 8 * fq;
#pragma unroll
                    for (int n = 0; n < 2; ++n) *(f32x4*)(oo + col + 4 * n) = (acc[ai][bj][m][n] * rstd) * fgv[bj][n];
                }
            }
    }
};

template <class Epi, class Sched_, bool ALIGN_EPI = false, bool SP2 = false>
__device__ __forceinline__ void gemm_phase(LAS unsigned char* lds, const Gemm g, const Sched_& S, const Epi& E) {
    const int tid = threadIdx.x, wid = __builtin_amdgcn_readfirstlane(tid >> 6), lane = tid & 63, wr = wid >> 2, wc = wid & 3, fr = lane & 15, fq = lane >> 4;
    const int K = g.K, nt = K / BK;
    unsigned voffA[2], voffB[2];
#pragma unroll
    for (int i = 0; i < 2; ++i) { int R, C; stage_rc(tid * 16 + i * 8192, R, C); const int Rb = Epi::PERM ? ((R & ~31) + perm32(R & 31)) : R;
        voffA[i] = (unsigned)(R * K + C) * 2u; voffB[i] = (unsigned)(Rb * K + C) * 2u; }
    const size_t kstep = (size_t)(BK * 2);
    const size_t hstep = (size_t)HALF * K * 2;
    const size_t tstep = 2 * hstep;
    const unsigned ldsw = (unsigned)wid * 1024u;
    const int aoff = lds_byte(wr * 64 + fr, fq * 8), boff = lds_byte(wc * 32 + fr, fq * 8);
#define PG8_SA(b, h) (((b) * 2 + (h)) * HTB)
#define PG8_SB(b, h) ((4 + (b) * 2 + (h)) * HTB)
#define PG8_STAGE(bufoff, gbase, voff) do { _Pragma("unroll") for (int _i = 0; _i < 2; ++_i) \
        __builtin_amdgcn_global_load_lds((const GAS unsigned*)((const char*)(gbase) + (voff)[_i]), (LAS unsigned*)(lds + (bufoff) + ldsw + _i * 8192), 16, 0, 0); } while (0)
#define PG8_LDA(dst, b, h) do { _Pragma("unroll") for (int m = 0; m < 4; ++m) _Pragma("unroll") for (int k = 0; k < 2; ++k) dst[m][k] = *(const LAS bf16x8*)(lds + PG8_SA(b, h) + aoff + m * 2048 + k * 1024); } while (0)
#define PG8_LDB(dst, b, h) do { _Pragma("unroll") for (int n = 0; n < 2; ++n) _Pragma("unroll") for (int k = 0; k < 2; ++k) dst[n][k] = *(const LAS bf16x8*)(lds + PG8_SB(b, h) + boff + n * 2048 + k * 1024); } while (0)
#define PG8_MMA(ai, bj, At, Bt) do { __builtin_amdgcn_s_setprio(1); _Pragma("unroll") for (int m = 0; m < 4; ++m) _Pragma("unroll") for (int n = 0; n < 2; ++n) _Pragma("unroll") for (int k = 0; k < 2; ++k) \
        acc[ai][bj][m][n] = __builtin_amdgcn_mfma_f32_16x16x32_bf16(Bt[n][k], At[m][k], acc[ai][bj][m][n], 0, 0, 0); __builtin_amdgcn_s_setprio(0); } while (0)
#define PG8_WAIT_V(n) asm volatile("s_waitcnt vmcnt(" #n ")" ::: "memory")
#define PG8_WAIT_L(n) asm volatile("s_waitcnt lgkmcnt(" #n ")" ::: "memory")
#define PG8_BAR __builtin_amdgcn_s_barrier()
#define PG8_SCHED __builtin_amdgcn_sched_barrier(0)
    Unit cur, nxt; int ui = 0;
    if (!S.next(0, cur)) return;
    f32x4 acc[2][2][4][2];
#pragma unroll
    for (int a = 0; a < 2; ++a)
#pragma unroll
        for (int b = 0; b < 2; ++b)
#pragma unroll
            for (int m = 0; m < 4; ++m)
#pragma unroll
                for (int n = 0; n < 2; ++n) acc[a][b][m][n] = (f32x4){0.f, 0.f, 0.f, 0.f};
    bf16x8 At[4][2], B0[2][2], B1[2][2];
    const char* cA = (const char*)g.A + (size_t)cur.pm * tstep; const char* cB = (const char*)g.Bt + (size_t)cur.pn * tstep;
    S.a_ready(cur);
    if constexpr (SP2) {
        PG8_STAGE(PG8_SB(0, 0), cB, voffB); PG8_STAGE(PG8_SB(0, 1), cB + hstep, voffB); PG8_STAGE(PG8_SA(0, 0), cA, voffA); PG8_STAGE(PG8_SA(0, 1), cA + hstep, voffA);
        if (wr == 1) PG8_BAR;
        PG8_WAIT_V(2); PG8_BAR;
        PG8_STAGE(PG8_SB(1, 0), cB + kstep, voffB); PG8_STAGE(PG8_SA(1, 0), cA + kstep, voffA); PG8_STAGE(PG8_SB(1, 1), cB + hstep + kstep, voffB);
        PG8_WAIT_V(6); PG8_BAR;
    } else {
        PG8_STAGE(PG8_SB(0, 0), cB, voffB); PG8_STAGE(PG8_SA(0, 0), cA, voffA); PG8_STAGE(PG8_SB(0, 1), cB + hstep, voffB); PG8_STAGE(PG8_SA(0, 1), cA + hstep, voffA);
        if (wr == 1) PG8_BAR;
        PG8_WAIT_V(4); PG8_BAR;
        PG8_STAGE(PG8_SB(1, 0), cB + kstep, voffB); PG8_STAGE(PG8_SA(1, 0), cA + kstep, voffA); PG8_STAGE(PG8_SB(1, 1), cB + hstep + kstep, voffB);
        PG8_WAIT_V(6); PG8_BAR;
    }
    for (;;) {
        const bool has_next = S.next(ui + 1, nxt);
        const char* nA = has_next ? (const char*)g.A + (size_t)nxt.pm * tstep : cA; const char* nB = has_next ? (const char*)g.Bt + (size_t)nxt.pn * tstep : cB;
        for (int t = 0; t < nt; t += 2) {
            const bool last = (t == nt - 2);
            const char* a1 = cA + (size_t)(t + 1) * kstep;
            const char* a2 = last ? nA : cA + (size_t)(t + 2) * kstep; const char* b2 = last ? nB : cB + (size_t)(t + 2) * kstep;
            const char* a3 = a2 + kstep; const char* b3 = b2 + kstep;
            if (last && has_next) S.a_ready(nxt);
            if constexpr (SP2) {
            PG8_LDB(B0, 0, 0); PG8_LDB(B1, 0, 1); PG8_SCHED; PG8_LDA(At, 0, 0); PG8_STAGE(PG8_SA(1, 1), a1 + hstep, voffA);
            PG8_WAIT_V(8); PG8_WAIT_L(0); PG8_BAR; PG8_MMA(0, 0, At, B0); PG8_MMA(0, 1, At, B1); PG8_BAR; PG8_SCHED;
            PG8_LDA(At, 0, 1); PG8_STAGE(PG8_SB(0, 0), b2, voffB); PG8_STAGE(PG8_SB(0, 1), b2 + hstep, voffB); PG8_STAGE(PG8_SA(0, 0), a2, voffA);
            PG8_WAIT_V(8); PG8_WAIT_L(0); PG8_BAR; PG8_MMA(1, 0, At, B0); PG8_MMA(1, 1, At, B1); PG8_BAR; PG8_SCHED;
            PG8_LDB(B0, 1, 0); PG8_LDB(B1, 1, 1); PG8_SCHED; PG8_LDA(At, 1, 0); PG8_STAGE(PG8_SA(0, 1), a2 + hstep, voffA);
            PG8_WAIT_V(8); PG8_WAIT_L(0); PG8_BAR; PG8_MMA(0, 0, At, B0); PG8_MMA(0, 1, At, B1); PG8_BAR; PG8_SCHED;
            PG8_LDA(At, 1, 1); PG8_STAGE(PG8_SB(1, 0), b3, voffB); PG8_STAGE(PG8_SB(1, 1), b3 + hstep, voffB); PG8_STAGE(PG8_SA(1, 0), a3, voffA);
            PG8_WAIT_V(8); PG8_WAIT_L(0); PG8_BAR; PG8_MMA(1, 0, At, B0); PG8_MMA(1, 1, At, B1); PG8_BAR; PG8_SCHED;
            } else {
            PG8_LDB(B0, 0, 0); PG8_SCHED; PG8_LDA(At, 0, 0); PG8_STAGE(PG8_SA(1, 1), a1 + hstep, voffA);
            PG8_WAIT_L(8); PG8_BAR; PG8_WAIT_L(0); PG8_MMA(0, 0, At, B0); PG8_BAR; PG8_SCHED;
            PG8_LDB(B1, 0, 1); PG8_STAGE(PG8_SB(0, 0), b2, voffB);
            PG8_BAR; PG8_WAIT_L(0); PG8_MMA(0, 1, At, B1); PG8_BAR;
            PG8_LDA(At, 0, 1); PG8_STAGE(PG8_SA(0, 0), a2, voffA);
            PG8_BAR; PG8_WAIT_L(0); PG8_MMA(1, 0, At, B0); PG8_BAR; PG8_SCHED;
            PG8_STAGE(PG8_SB(0, 1), b2 + hstep, voffB);
            PG8_WAIT_V(6); PG8_BAR; PG8_MMA(1, 1, At, B1); PG8_BAR;
            PG8_LDB(B0, 1, 0); PG8_SCHED; PG8_LDA(At, 1, 0); PG8_STAGE(PG8_SA(0, 1), a2 + hstep, voffA);
            PG8_WAIT_L(8); PG8_BAR; PG8_WAIT_L(0); PG8_MMA(0, 0, At, B0); PG8_BAR; PG8_SCHED;
            PG8_LDB(B1, 1, 1); PG8_STAGE(PG8_SB(1, 0), b3, voffB);
            PG8_BAR; PG8_WAIT_L(0); PG8_MMA(0, 1, At, B1); PG8_BAR;
            PG8_LDA(At, 1, 1); PG8_STAGE(PG8_SA(1, 0), a3, voffA);
            PG8_BAR; PG8_WAIT_L(0); PG8_MMA(1, 0, At, B0); PG8_BAR; PG8_SCHED;
            PG8_STAGE(PG8_SB(1, 1), b3 + hstep, voffB);
            PG8_WAIT_V(6); PG8_BAR; PG8_MMA(1, 1, At, B1); PG8_BAR;
            }
        }
        if constexpr (ALIGN_EPI) { if (wr == 0) PG8_BAR; }
        if constexpr (Epi::XCHG) { E.xchg(acc, cur, wr, wc, fr, fq, lds + STAGE_BYTES); S.done(cur); }
        else if constexpr (!Epi::AFTER_DRAIN) { E(acc, cur, wr, wc, fr, fq); S.done(cur); }
        if (!has_next) break;
#pragma unroll
        for (int a = 0; a < 2; ++a)
#pragma unroll
            for (int b = 0; b < 2; ++b)
#pragma unroll
                for (int m = 0; m < 4; ++m)
#pragma unroll
                    for (int n = 0; n < 2; ++n) acc[a][b][m][n] = (f32x4){0.f, 0.f, 0.f, 0.f};
        cur = nxt; cA = nA; cB = nB; ++ui;
        if constexpr (ALIGN_EPI) { if (wr == 1) PG8_BAR; }
    }
    PG8_WAIT_V(0);
    if constexpr (!ALIGN_EPI) { if (wr == 0) PG8_BAR; }
    PG8_BAR;
    if constexpr (Epi::AFTER_DRAIN) { E.fused(acc, cur, wr, wc, fr, fq, lds, wid, lane); S.done(cur); }
#undef PG8_SA
#undef PG8_SB
#undef PG8_STAGE
#undef PG8_LDA
#undef PG8_LDB
#undef PG8_MMA
#undef PG8_WAIT_V
#undef PG8_WAIT_L
#undef PG8_BAR
#undef PG8_SCHED
}
}

struct Args { const float* in[23]; float* out; unsigned char* ws; int ph_lo, ph_hi; };
enum { I_X = 0, I_C, I_CTX, I_CCTX, I_L0_NG, I_L0_WADA, I_L0_BADA, I_L0_WIN, I_L0_SINK, I_L0_WOUT,
       I_L1_NG, I_L1_WADA, I_L1_BADA, I_L1_WIN, I_L1_WA1F, I_L1_WA2F, I_L1_BAF, I_L1_WA1B, I_L1_WA2B, I_L1_BAB, I_L1_HNG, I_L1_WOUT, I_FNG };

__device__ __forceinline__ void p0_transpose_item(const float* W, int K, int N, bf16_t* WT, LAS float* scr, int item, int lane) {
    const int nblk = N / 32, kb = item / nblk, nb = item % nblk, k0 = 64 * kb, n0 = 32 * nb;
#pragma unroll 8
    for (int i = 0; i < 32; ++i) { const int kk = 2 * i + (lane >> 5); scr[kk * 33 + (lane & 31)] = W[(size_t)(k0 + kk) * N + n0 + (lane & 31)]; }
    asm volatile("s_waitcnt lgkmcnt(0)" ::: "memory");
    const int c = lane & 7;
#pragma unroll
    for (int j = 0; j < 4; ++j) { const int n = (lane >> 3) + 8 * j; const LAS float* s = scr + (8 * c) * 33 + n;
        u32x4 o; o.x = cvt_pk_bf16(s[0 * 33], s[1 * 33]); o.y = cvt_pk_bf16(s[2 * 33], s[3 * 33]); o.z = cvt_pk_bf16(s[4 * 33], s[5 * 33]); o.w = cvt_pk_bf16(s[6 * 33], s[7 * 33]);
        *(u32x4*)(WT + (size_t)(n0 + n) * K + k0 + 8 * c) = o; }
    asm volatile("s_waitcnt lgkmcnt(0)" ::: "memory");
}

__device__ __forceinline__ void p0_prologue(const Args& a, LAS unsigned char* lds, int bid, int nb, int part) {
    const int tid = threadIdx.x, lane = tid & 63, wave = tid >> 6;
    unsigned char* ws = a.ws;
    {
        LAS float* sc = (LAS float*)lds;
        LAS float* red = sc + 9 * 1024;
        bool loaded = false;
        const int layer = part;
        const int COLS = part ? 32 : 16, NKG = 512 / COLS, NGRP = 3072 / COLS;
        for (int grp = bid; grp < NGRP; grp += nb) {
            if (!loaded) {
                for (int i = tid; i < 9 * 1024; i += 512) { const float cv = i < 8192 ? a.in[I_C][i] : a.in[I_CCTX][i - 8192]; sc[i] = silu_f(cv); }
                loaded = true;
            }
            __syncthreads();
            const int n0 = grp * COLS;
            const float* W = layer ? a.in[I_L1_WADA] : a.in[I_L0_WADA]; const float* bias = layer ? a.in[I_L1_BADA] : a.in[I_L0_BADA];
            float* mod = (float*)(ws + (layer ? WS_MOD1 : WS_MOD0));
            const int col = tid & (COLS - 1), kg = tid / COLS;
            float acc[9];
#pragma unroll
            for (int v = 0; v < 9; ++v) acc[v] = 0.f;
            for (int k0 = kg; k0 < 1024; k0 += 8 * NKG) {
                float w[8];
#pragma unroll
                for (int u = 0; u < 8; ++u) w[u] = W[(size_t)(k0 + u * NKG) * 3072 + n0 + col];
#pragma unroll
                for (int u = 0; u < 8; ++u)
#pragma unroll
                    for (int v = 0; v < 9; ++v) acc[v] += sc[v * 1024 + k0 + u * NKG] * w[u];
            }
#pragma unroll
            for (int v = 0; v < 9; ++v) red[(kg * 9 + v) * COLS + col] = acc[v];
            __syncthreads();
            if (tid < 9 * COLS) {
                const int v = tid / COLS, cc = tid & (COLS - 1); float s2 = bias[n0 + cc];
                for (int g2 = 0; g2 < NKG; ++g2) s2 += red[(g2 * 9 + v) * COLS + cc];
                if (layer) mod[v * 3072 + n0 + cc] = s2;
                else __hip_atomic_store((unsigned*)mod + v * 3072 + n0 + cc, __builtin_bit_cast(unsigned, s2) | 1u, __ATOMIC_RELAXED, __HIP_MEMORY_SCOPE_AGENT);
            }
        }
        __syncthreads();
    }
    if (part == 0) {
        float* cosT = (float*)(ws + WS_ROPE); float* sinT = cosT + 1024;
        const int gt = bid * 512 + tid;
        if (gt < 1024) { const int p = gt >> 4, f = gt & 15; const float inv = powf(10000.f, -(float)f / 16.f); const float ang = (float)p * inv; cosT[gt] = cosf(ang); sinT[gt] = sinf(ang); }
    } else {
        bf16_t* WT1 = (bf16_t*)(ws + WS_WT1);
        for (int i = bid * 512 + tid; i < 256 * 1024; i += nb * 512) {
            const int r = i >> 10, k = i & 1023; float v = 0.f;
            if (r < 16) v = a.in[I_L1_WA1F][k * 16 + r]; else if (r < 32) v = a.in[I_L1_WA1B][k * 16 + (r - 16)];
            WT1[(size_t)(3072 + r) * 1024 + k] = f2bf(v);
        }
    }
    {
        LAS float* scr = (LAS float*)(lds + wave * 16384);
        const int gw = bid * 8 + wave, NGW = nb * 8;
        constexpr int I0 = 16 * (N0 / 32), IO = 16 * (D / 32), I1 = 16 * (N1 / 32);
        if (part == 0) {
            for (int it = gw; it < I0; it += NGW) p0_transpose_item(a.in[I_L0_WIN], D, N0, (bf16_t*)(ws + WS_WT0), scr, it, lane);
        } else {
            for (int it = gw; it < IO + I1 + IO; it += NGW) {
                int r = it;
                if (r < IO) { p0_transpose_item(a.in[I_L0_WOUT], D, D, (bf16_t*)(ws + WS_WO0), scr, r, lane); continue; } r -= IO;
                if (r < I1) { p0_transpose_item(a.in[I_L1_WIN], D, N1, (bf16_t*)(ws + WS_WT1), scr, r, lane); continue; } r -= I1;
                p0_transpose_item(a.in[I_L1_WOUT], D, D, (bf16_t*)(ws + WS_WO1), scr, r, lane);
            }
        }
    }
}

__device__ __forceinline__ void norm_mod_phase(const float* xl, const float* xc, const float* ng, const float* mod, bf16_t* H, int G) {
    const int lane = threadIdx.x & 63, wave = threadIdx.x >> 6;
    for (int row = blockIdx.x * 8 + wave; row < MT; row += G * 8) {
        const float* xr = row < ML ? xl + (size_t)row * D : xc + (size_t)(row - ML) * D;
        const int v = row < ML ? (row >> 11) : 8;
        const float* sh = mod + v * 3072; const float* scl = sh + 1024;
        f32x4 x[4]; float ss = 0.f;
#pragma unroll
        for (int j = 0; j < 4; ++j) { x[j] = *(const f32x4*)(xr + 4 * lane + 256 * j); ss += (x[j][0] * x[j][0] + x[j][1] * x[j][1]) + (x[j][2] * x[j][2] + x[j][3] * x[j][3]); }
        const float rstd = rsqrtf(wave_sum(ss) * (1.f / D) + EPS);
#pragma unroll
        for (int j = 0; j < 4; ++j) {
            const int c = 4 * lane + 256 * j;
            const f32x4 g = *(const f32x4*)(ng + c), s1 = *(const f32x4*)(scl + c), s0 = *(const f32x4*)(sh + c);
            const f32x4 y = (x[j] * rstd) * g * (s1 + 1.f) + s0;
            u32x2 w; w.x = cvt_pk_bf16(y[0], y[1]); w.y = cvt_pk_bf16(y[2], y[3]);
            *(u32x2*)(H + (size_t)row * D + c) = w;
        }
    }
}

__device__ __forceinline__ void norm_mod_wait_phase(const float* xl, const float* xc, const float* ng, const float* mod, bf16_t* H, int G) {
    const int lane = threadIdx.x & 63, wave = threadIdx.x >> 6;
    const int gw = blockIdx.x * 8 + wave, NW = G * 8;
    const int v = gw % 9, wi = gw / 9, nv = (NW - v + 8) / 9;
    if (wi >= 2048) return;
    const float* xbase = v < 8 ? xl + (size_t)v * SEQ * D : xc;
    bf16_t* hbase = H + (size_t)(v < 8 ? v * SEQ : ML) * D;
    f32x4 gm[4], sh[4];
    {
        unsigned* mw = (unsigned*)mod + v * 3072;
#pragma unroll
        for (int j = 0; j < 4; ++j) {
            const int c = 4 * lane + 256 * j;
            const f32x4 g = *(const f32x4*)(ng + c);
#pragma unroll
            for (int i = 0; i < 4; ++i) {
                unsigned a = __hip_atomic_load(mw + c + i, __ATOMIC_RELAXED, __HIP_MEMORY_SCOPE_AGENT), bsc = __hip_atomic_load(mw + 1024 + c + i, __ATOMIC_RELAXED, __HIP_MEMORY_SCOPE_AGENT); unsigned sp = 0;
                while ((a == 0u || bsc == 0u) && ++sp < (1u << 22)) { __builtin_amdgcn_s_sleep(2); a = __hip_atomic_load(mw + c + i, __ATOMIC_RELAXED, __HIP_MEMORY_SCOPE_AGENT); bsc = __hip_atomic_load(mw + 1024 + c + i, __ATOMIC_RELAXED, __HIP_MEMORY_SCOPE_AGENT); }
                sh[j][i] = __builtin_bit_cast(float, a); gm[j][i] = g[i] * (__builtin_bit_cast(float, bsc) + 1.f);
            }
        }
    }
    for (int r = wi; r < 2048; r += nv) {
        const float* xr = xbase + (size_t)r * D;
        f32x4 x[4]; float ss = 0.f;
#pragma unroll
        for (int j = 0; j < 4; ++j) { x[j] = *(const f32x4*)(xr + 4 * lane + 256 * j); ss += (x[j][0] * x[j][0] + x[j][1] * x[j][1]) + (x[j][2] * x[j][2] + x[j][3] * x[j][3]); }
        const float rstd = rsqrtf(wave_sum(ss) * (1.f / D) + EPS);
#pragma unroll
        for (int j = 0; j < 4; ++j) {
            const f32x4 y = (x[j] * rstd) * gm[j] + sh[j];
            u32x2 w; w.x = cvt_pk_bf16(y[0], y[1]); w.y = cvt_pk_bf16(y[2], y[3]);
            *(u32x2*)(hbase + (size_t)r * D + 4 * lane + 256 * j) = w;
        }
    }
}

__device__ __forceinline__ void norm_mod_bf16_phase(const bf16_t* X, const float* ng, const float* mod, bf16_t* H, int G) {
    const int lane = threadIdx.x & 63, wave = threadIdx.x >> 6;
    for (int row = blockIdx.x * 8 + wave; row < MT; row += G * 8) {
        const bf16_t* xr = X + (size_t)row * D;
        const int v = row < ML ? (row >> 11) : 8;
        const float* sh = mod + v * 3072; const float* scl = sh + 1024;
        float x[16]; float ss = 0.f;
#pragma unroll
        for (int j = 0; j < 2; ++j) {
            const u32x4 u = *(const u32x4*)(xr + 8 * lane + 512 * j);
#pragma unroll
            for (int i = 0; i < 4; ++i) { x[8 * j + 2 * i] = bflo(u[i]); x[8 * j + 2 * i + 1] = bfhi(u[i]); }
        }
#pragma unroll
        for (int i = 0; i < 16; ++i) ss += x[i] * x[i];
        const float rstd = rsqrtf(wave_sum(ss) * (1.f / D) + EPS);
#pragma unroll
        for (int j = 0; j < 2; ++j) {
            const int c = 8 * lane + 512 * j;
            unsigned w[4];
#pragma unroll
            for (int i = 0; i < 2; ++i) {
                const f32x4 g = *(const f32x4*)(ng + c + 4 * i), s1 = *(const f32x4*)(scl + c + 4 * i), s0 = *(const f32x4*)(sh + c + 4 * i);
                const f32x4 xv = (f32x4){x[8 * j + 4 * i], x[8 * j + 4 * i + 1], x[8 * j + 4 * i + 2], x[8 * j + 4 * i + 3]};
                const f32x4 y = (xv * rstd) * g * (s1 + 1.f) + s0;
                w[2 * i] = cvt_pk_bf16(y[0], y[1]); w[2 * i + 1] = cvt_pk_bf16(y[2], y[3]);
            }
            *(u32x4*)(H + (size_t)row * D + c) = (u32x4){w[0], w[1], w[2], w[3]};
        }
    }
}

__device__ __forceinline__ void attn_phase(const bf16_t* QKVG, const float* sink, bf16_t* OG, LAS unsigned char* lds, int G) {
    const int tid = threadIdx.x, lane = tid & 63, wave = tid >> 6, fr = lane & 15, fq = lane >> 4;
    LAS bf16_t* sK = (LAS bf16_t*)lds;
    constexpr float LOG2E = 1.4426950408889634f;
    for (int unit = blockIdx.x; unit < 576; unit += G) {
        int b, kvh, qc, rowbase; bool lat;
        if (unit < 64) { lat = true; const int gk = unit >> 2, e = unit & 3; b = gk >> 1; kvh = gk & 1; qc = e < 2 ? e : 28 + e; rowbase = b * SEQ + qc * 64; }
        else if (unit < 512) { lat = true; const int v = unit - 64, gk = v / 28; b = gk >> 1; kvh = gk & 1; qc = 2 + v % 28; rowbase = b * SEQ + qc * 64; }
        else { const int u2 = unit - 512; lat = false; b = u2 >> 3; kvh = (u2 >> 2) & 1; qc = u2 & 3; rowbase = ML + b * CTXL + qc * 64; }
        const int head = kvh * 8 + wave;
        bf16x8 Bq[4][2];
#pragma unroll
        for (int qt = 0; qt < 4; ++qt)
#pragma unroll
            for (int ks = 0; ks < 2; ++ks) Bq[qt][ks] = *(const bf16x8*)(QKVG + (size_t)(rowbase + qt * 16 + fr) * N0 + head * 64 + ks * 32 + fq * 8);
        float mfix[4], lrun[4]; f32x4 O[4][4];
        const float sk2 = sink[head] * LOG2E;
#pragma unroll
        for (int qt = 0; qt < 4; ++qt) { mfix[qt] = 0.f; lrun[qt] = 0.f;
#pragma unroll
            for (int dt = 0; dt < 4; ++dt) O[dt][qt] = (f32x4){0.f, 0.f, 0.f, 0.f}; }
        const int jlo = lat ? (qc < 2 ? 2 - qc : 0) : 0, jhi = lat ? (33 - qc < 4 ? 33 - qc : 4) : -1, nloc = jhi - jlo + 1, T = nloc + 4;
#define ATT_ROW(n_) ((n_) < nloc ? b * SEQ + 64 * (qc - 2 + jlo + (n_)) : ML + b * CTXL + 64 * ((n_) - nloc))
#define ATT_LOAD(n_) do { const bf16_t* src_ = QKVG + (size_t)(ATT_ROW(n_) + lkey) * N0 + 1024 + kvh * 64 + lch * 8; pkv = *(const u32x4*)src_; pvv = *(const u32x4*)(src_ + 128); } while (0)
#define ATT_STAGE(buf_) do { *(LAS u32x4*)(sK + (buf_) * ABUF + lkey * 72 + lch * 8) = pkv; *(LAS u32x4*)(sK + (buf_) * ABUF + 64 * 72 + lkey * 72 + lch * 8) = pvv; } while (0)
#define ATT_H2(buf_) do { const LAS bf16_t* cV_ = sK + (buf_) * ABUF + 64 * 72; \
            _Pragma("unroll") for (int dt = 0; dt < 4; ++dt) _Pragma("unroll") for (int s2 = 0; s2 < 2; ++s2) { \
                const s16x4 lo_ = lds_tr4(cV_ + (32 * s2 + 4 * fq + (fr >> 2)) * 72 + dt * 16 + 4 * (fr & 3)), hi_ = lds_tr4(cV_ + (32 * s2 + 16 + 4 * fq + (fr >> 2)) * 72 + dt * 16 + 4 * (fr & 3)); \
                const bf16x8 av_ = __builtin_shufflevector(lo_, hi_, 0, 1, 2, 3, 4, 5, 6, 7); \
                _Pragma("unroll") for (int qt = 0; qt < 4; ++qt) O[dt][qt] = __builtin_amdgcn_mfma_f32_16x16x32_bf16(av_, Bp[s2][qt], O[dt][qt], 0, 0, 0); } } while (0)
        constexpr int ABUF = 2 * 64 * 72;
        const int lkey = tid >> 3, lch = tid & 7;
        const int grp = __builtin_amdgcn_readfirstlane(wave >> 2);
        u32x4 pkv, pvv;
        ATT_LOAD(0);
        __syncthreads();
        ATT_STAGE(0);
        ATT_LOAD(1);
        ATT_STAGE(1);
        if (T > 2) ATT_LOAD(2);
        __syncthreads();
        bf16x8 Bp[2][4];
        int bcur = 0;
#define ATT_NEXT_STAGE() do { if (n + 2 < T) { const int b2_ = bcur == 0 ? 2 : bcur - 1; ATT_STAGE(b2_); if (n + 3 < T) ATT_LOAD(n + 3); } } while (0)
        for (int n = 0; n < T; ++n) {
            if (grp == 0) { LDS_BARRIER(); ATT_NEXT_STAGE(); }
            const int jj = jlo + n; const int kind = (n < nloc) ? (jj == 0 ? 1 : (jj == 4 ? 2 : 0)) : 0;
            const LAS bf16_t* cK = sK + bcur * ABUF;
#pragma unroll
            for (int hq = 0; hq < 2; ++hq) {
                f32x4 St[4][2];
#pragma unroll
                for (int kt = 0; kt < 4; ++kt) {
                    const bf16x8 a0 = *(const LAS bf16x8*)(cK + (kt * 16 + fr) * 72 + fq * 8), a1 = *(const LAS bf16x8*)(cK + (kt * 16 + fr) * 72 + 32 + fq * 8);
#pragma unroll
                    for (int q2 = 0; q2 < 2; ++q2) {
                        const float ci = -mfix[2 * hq + q2];
                        f32x4 c = (f32x4){ci, ci, ci, ci};
                        c = __builtin_amdgcn_mfma_f32_16x16x32_bf16(a0, Bq[2 * hq + q2][0], c, 0, 0, 0);
                        c = __builtin_amdgcn_mfma_f32_16x16x32_bf16(a1, Bq[2 * hq + q2][1], c, 0, 0, 0);
                        St[kt][q2] = c;
                    }
                }
                if (kind != 0) {
#pragma unroll
                    for (int kt = 0; kt < 4; ++kt)
#pragma unroll
                        for (int q2 = 0; q2 < 2; ++q2)
#pragma unroll
                            for (int r = 0; r < 4; ++r) { const int kk = kt * 16 + 4 * fq + r, qq = (2 * hq + q2) * 16 + fr; const bool ok = (kind == 1) ? (kk >= qq) : (kk <= qq); if (!ok) St[kt][q2][r] = -1e30f; }
                }
#pragma unroll
                for (int q2 = 0; q2 < 2; ++q2) {
                    const int qt = 2 * hq + q2;
                    if (n == 0) {
                        float mx = -1e30f;
#pragma unroll
                        for (int kt = 0; kt < 4; ++kt)
#pragma unroll
                            for (int r = 0; r < 4; ++r) mx = fmaxf(mx, St[kt][q2][r]);
                        mx = fmaxf(mx, __shfl_xor(mx, 16)); mx = fmaxf(mx, __shfl_xor(mx, 32));
                        const float mf = fmaxf(mx, sk2);
                        mfix[qt] = mf; lrun[qt] = (fq == 0) ? __builtin_amdgcn_exp2f(sk2 - mf) : 0.f;
#pragma unroll
                        for (int kt = 0; kt < 4; ++kt) St[kt][q2] = St[kt][q2] - mf;
                    }
                    float ls = 0.f;
#pragma unroll
                    for (int kt = 0; kt < 4; ++kt)
#pragma unroll
                        for (int r = 0; r < 4; ++r) { const float p = __builtin_amdgcn_exp2f(St[kt][q2][r]); St[kt][q2][r] = p; ls += p; asm("" : "+v"(ls)); }
                    lrun[qt] += ls;
#pragma unroll
                    for (int s = 0; s < 2; ++s) {
                        u32x4 w; w.x = cvt_pk_bf16(St[2 * s][q2][0], St[2 * s][q2][1]); w.y = cvt_pk_bf16(St[2 * s][q2][2], St[2 * s][q2][3]);
                        w.z = cvt_pk_bf16(St[2 * s + 1][q2][0], St[2 * s + 1][q2][1]); w.w = cvt_pk_bf16(St[2 * s + 1][q2][2], St[2 * s + 1][q2][3]);
                        Bp[s][qt] = __builtin_bit_cast(bf16x8, w);
                    }
                }
            }
            if (grp == 1) { LDS_BARRIER(); ATT_NEXT_STAGE(); }
            ATT_H2(bcur);
            bcur = bcur == 2 ? 0 : bcur + 1;
        }
#undef ATT_NEXT_STAGE
#undef ATT_ROW
#undef ATT_LOAD
#undef ATT_STAGE
#undef ATT_H2
        u32x2 gv[4][4];
#pragma unroll
        for (int qt = 0; qt < 4; ++qt)
#pragma unroll
            for (int dt = 0; dt < 4; ++dt) gv[qt][dt] = *(const u32x2*)(QKVG + (size_t)(rowbase + qt * 16 + fr) * N0 + 1280 + head * 64 + dt * 16 + 4 * fq);
#pragma unroll
        for (int qt = 0; qt < 4; ++qt) {
            float l = lrun[qt]; l += __shfl_xor(l, 16); l += __shfl_xor(l, 32);
            const float inv = __builtin_amdgcn_rcpf(l);
            const size_t row = (size_t)(rowbase + qt * 16 + fr);
#pragma unroll
            for (int dt = 0; dt < 4; ++dt) {
                const int dcol = head * 64 + dt * 16 + 4 * fq;
                const u32x2 g2 = gv[qt][dt];
                const float o0 = O[dt][qt][0] * inv * silu_f(bflo(g2.x)), o1 = O[dt][qt][1] * inv * silu_f(bfhi(g2.x));
                const float o2 = O[dt][qt][2] * inv * silu_f(bflo(g2.y)), o3 = O[dt][qt][3] * inv * silu_f(bfhi(g2.y));
                u32x2 w; w.x = cvt_pk_bf16(o0, o1); w.y = cvt_pk_bf16(o2, o3);
                *(u32x2*)(OG + row * D + dcol) = w;
            }
        }
    }
    __syncthreads();
}

__device__ __forceinline__ float log_sigmoid_f(float z) { return fminf(z, 0.f) - __logf(1.f + __expf(-fabsf(z))); }
__device__ __forceinline__ void gla_prep_phase(const Args& a, bf16_t* QKVG, const float* R, bf16_t* QDB, bf16_t* KIB, float* DEC, LAS unsigned char* lds, int G) {
    const int tid = threadIdx.x, d = tid & 127, tq = tid >> 7;
    LAS float* rS = (LAS float*)lds;
    LAS float* totS = rS + 2048;
    for (int item = blockIdx.x; item < 1152; item += G) {
        const int b = item / 144, rem = item % 144, h = rem / 36, cidx = rem % 36;
        const int row0 = cidx < 4 ? ML + b * CTXL + 64 * cidx : b * SEQ + 64 * (cidx - 4);
        __syncthreads();
        *(LAS f32x4*)(rS + tid * 4) = *(const f32x4*)(R + (size_t)(row0 + (tid >> 3)) * 32 + (tid & 7) * 4);
        bf16_t kraw[16], qraw[16];
#pragma unroll
        for (int tt = 0; tt < 16; ++tt) {
            const bf16_t* qk = QKVG + (size_t)(row0 + 16 * tq + tt) * N1 + h * 128 + d;
            kraw[tt] = qk[512]; qraw[tt] = (cidx >= 4) ? qk[0] : (bf16_t)0;
        }
        float wf[16], wb[16];
#pragma unroll
        for (int j = 0; j < 16; ++j) { wf[j] = a.in[I_L1_WA2F][j * 512 + h * 128 + d]; wb[j] = a.in[I_L1_WA2B][j * 512 + h * 128 + d]; }
        const float baf = a.in[I_L1_BAF][h * 128 + d], bab = a.in[I_L1_BAB][h * 128 + d];
        __syncthreads();
        float laf[16], lab[16];
#pragma unroll
        for (int tt = 0; tt < 16; ++tt) {
            const LAS float* rr = rS + (16 * tq + tt) * 32;
            float zf = baf, zb = bab;
#pragma unroll
            for (int j4 = 0; j4 < 4; ++j4) {
                const f32x4 rf = *(const LAS f32x4*)(rr + 4 * j4), rb = *(const LAS f32x4*)(rr + 16 + 4 * j4);
#pragma unroll
                for (int j = 0; j < 4; ++j) { zf += rf[j] * wf[4 * j4 + j]; zb += rb[j] * wb[4 * j4 + j]; }
            }
            laf[tt] = log_sigmoid_f(zf) * (1.f / 16.f); lab[tt] = log_sigmoid_f(zb) * (1.f / 16.f);
        }
#pragma unroll
        for (int tt = 1; tt < 16; ++tt) laf[tt] += laf[tt - 1];
#pragma unroll
        for (int tt = 14; tt >= 0; --tt) lab[tt] += lab[tt + 1];
        totS[tq * 128 + d] = laf[15]; totS[512 + tq * 128 + d] = lab[0];
        __syncthreads();
        float offf = 0.f, offb = 0.f, totf = 0.f, totb = 0.f;
#pragma unroll
        for (int q2 = 0; q2 < 4; ++q2) { const float tf = totS[q2 * 128 + d], tb = totS[512 + q2 * 128 + d]; totf += tf; totb += tb; if (q2 < tq) offf += tf; if (q2 > tq) offb += tb; }
        if (tq == 0) { DEC[(size_t)(((0 * 8 + b) * 4 + h) * 36 + cidx) * 128 + d] = __expf(totf); DEC[(size_t)(((1 * 8 + b) * 4 + h) * 36 + cidx) * 128 + d] = __expf(totb); }
#pragma unroll
        for (int tt = 0; tt < 16; ++tt) {
            const size_t row = (size_t)(row0 + 16 * tq + tt);
            const float cf = laf[tt] + offf, cb = lab[tt] + offb;
            bf16_t* qk = QKVG + row * N1 + h * 128 + d;
            const float k = bf2f(kraw[tt]);
            qk[512] = f2bf(k * __expf(-cf));
            KIB[row * 512 + h * 128 + d] = f2bf(k * __expf(-cb));
            if (cidx >= 4) { const float q = bf2f(qraw[tt]); qk[0] = f2bf(q * __expf(cf)); QDB[row * 512 + h * 128 + d] = f2bf(q * __expf(cb)); }
        }
    }
    __syncthreads();
}

__device__ __forceinline__ void gla_phase(const bf16_t* QKVG, const bf16_t* QDB, const bf16_t* KIB, const float* DEC, bf16_t* OFB, LAS unsigned char* lds, int G) {
    const int tid = threadIdx.x, lane = tid & 63, wave = tid >> 6, fr = lane & 15, fq = lane >> 4;
    const int et = wave & 3, hf = __builtin_amdgcn_readfirstlane(wave >> 2);
    constexpr int IMG = 2 * 64 * 136 + 64 * 72;
    LAS bf16_t* IMG0 = (LAS bf16_t*)lds;
    LAS bf16_t* AL = IMG0 + 2 * IMG;
    LAS float* DC0 = (LAS float*)(AL + 64 * 72);
    LAS float* OX = DC0 + 256;
    for (int unit = blockIdx.x; unit < 256; unit += G) {
        const int xj = unit >> 3, eq = xj & 3, gsel = (xj >> 2) * 8 + (unit & 7), dir = gsel & 1, h = (gsel >> 1) & 3, b = gsel >> 3;
        const bf16_t* qd_base = dir ? QDB + h * 128 : QKVG + h * 128; const size_t qd_pitch = dir ? 512 : N1;
        const bf16_t* ki_base = dir ? KIB + h * 128 : QKVG + 512 + h * 128; const size_t ki_pitch = dir ? 512 : N1;
        const bf16_t* v_base = QKVG + 1024 + h * 256 + eq * 64;
        const float* dec_base = DEC + (size_t)(((dir * 8 + b) * 4 + h) * 36) * 128;
        bf16_t* OUT = OFB + (size_t)dir * ML * D + h * 256 + eq * 64;
        f32x4 S[4];
#pragma unroll
        for (int i = 0; i < 4; ++i) S[i] = (f32x4){0.f, 0.f, 0.f, 0.f};
        u32x4 pq[2], pk[2], pv; float pdec = 0.f;
#define GLA_LOAD(step_) do { const int cx_ = dir ? ((step_) < 4 ? 3 - (step_) : 39 - (step_)) : (step_); \
            const int r0_ = cx_ < 4 ? ML + b * CTXL + 64 * cx_ : b * SEQ + 64 * (cx_ - 4); \
            _Pragma("unroll") for (int i_ = 0; i_ < 2; ++i_) { const int idx_ = tid + 512 * i_, pr_ = idx_ >> 4, c16_ = idx_ & 15; const size_t gr_ = (size_t)(r0_ + (dir ? 63 - pr_ : pr_)); \
                pq[i_] = (cx_ >= 4) ? *(const u32x4*)(qd_base + gr_ * qd_pitch + c16_ * 8) : (u32x4){0u, 0u, 0u, 0u}; \
                pk[i_] = *(const u32x4*)(ki_base + gr_ * ki_pitch + c16_ * 8); } \
            { const int pr_ = tid >> 3, c8_ = tid & 7; pv = *(const u32x4*)(v_base + (size_t)(r0_ + (dir ? 63 - pr_ : pr_)) * N1 + c8_ * 8); } \
            if (tid < 128) pdec = dec_base[cx_ * 128 + tid]; } while (0)
#define GLA_STAGE(buf_) do { LAS bf16_t* q_ = IMG0 + (buf_) * IMG; \
            _Pragma("unroll") for (int i_ = 0; i_ < 2; ++i_) { const int idx_ = tid + 512 * i_, pr_ = idx_ >> 4, c16_ = idx_ & 15; \
                *(LAS u32x4*)(q_ + pr_ * 136 + c16_ * 8) = pq[i_]; *(LAS u32x4*)(q_ + 64 * 136 + pr_ * 136 + c16_ * 8) = pk[i_]; } \
            *(LAS u32x4*)(q_ + 2 * 64 * 136 + (tid >> 3) * 72 + (tid & 7) * 8) = pv; \
            if (tid < 128) DC0[(buf_) * 128 + tid] = pdec; } while (0)
        GLA_LOAD(0);
        __syncthreads();
        GLA_STAGE(0);
        GLA_LOAD(1);
        __syncthreads();
        for (int step = 0; step < 36; ++step) {
            const int cidx = dir ? (step < 4 ? 3 - step : 39 - step) : step;
            const bool lat = step >= 4;
            const int row0 = cidx < 4 ? ML + b * CTXL + 64 * cidx : b * SEQ + 64 * (cidx - 4);
            const int cur = step & 1;
            const LAS bf16_t* QD = IMG0 + cur * IMG; const LAS bf16_t* KI = QD + 64 * 136; const LAS bf16_t* VS = KI + 64 * 136; const LAS float* DC = DC0 + cur * 128;
            if (lat) {
                const int st = wave >> 1;
#pragma unroll
                for (int x = 0; x < 2; ++x) {
                    const int tt = 2 * (wave & 1) + x;
                    f32x4 c = (f32x4){0.f, 0.f, 0.f, 0.f};
                    if (st <= tt) {
#pragma unroll
                        for (int ks = 0; ks < 4; ++ks) {
                            const bf16x8 ak = *(const LAS bf16x8*)(KI + (16 * st + fr) * 136 + 32 * ks + 8 * fq), bq = *(const LAS bf16x8*)(QD + (16 * tt + fr) * 136 + 32 * ks + 8 * fq);
                            c = __builtin_amdgcn_mfma_f32_16x16x32_bf16(ak, bq, c, 0, 0, 0);
                        }
                        if (st == tt) {
#pragma unroll
                            for (int r = 0; r < 4; ++r) if (4 * fq + r > fr) c[r] = 0.f;
                        }
                    }
                    u32x2 w; w.x = cvt_pk_bf16(c[0], c[1]); w.y = cvt_pk_bf16(c[2], c[3]);
                    *(LAS u32x2*)(AL + (16 * tt + fr) * 72 + 16 * st + 4 * fq) = w;
                }
            }
            LDS_BARRIER();
            if (step + 1 < 36) { GLA_STAGE(cur ^ 1); if (step + 2 < 36) GLA_LOAD(step + 2); }
            bf16x8 vf[2], aK[4][2], bA[2][2], bq[2][4]; f32x4 dc[4];
#pragma unroll
            for (int ks = 0; ks < 2; ++ks) {
                const s16x4 lo = lds_tr4(VS + (32 * ks + 8 * fq + (fr >> 2)) * 72 + 16 * et + 4 * (fr & 3)), hi = lds_tr4(VS + (32 * ks + 8 * fq + 4 + (fr >> 2)) * 72 + 16 * et + 4 * (fr & 3));
                vf[ks] = __builtin_shufflevector(lo, hi, 0, 1, 2, 3, 4, 5, 6, 7);
            }
            if (lat) {
#pragma unroll
                for (int x = 0; x < 2; ++x)
#pragma unroll
                    for (int ks = 0; ks < 2; ++ks) bA[x][ks] = *(const LAS bf16x8*)(AL + (16 * (2 * hf + x) + fr) * 72 + 32 * ks + 8 * fq);
#pragma unroll
                for (int kk = 0; kk < 2; ++kk)
#pragma unroll
                    for (int tt = 0; tt < 4; ++tt) {
                        const int k2 = 2 * hf + kk;
                        const s16x4 lo = *(const LAS s16x4*)(QD + (16 * tt + fr) * 136 + 32 * k2 + 4 * fq), hi = *(const LAS s16x4*)(QD + (16 * tt + fr) * 136 + 32 * k2 + 16 + 4 * fq);
                        bq[kk][tt] = __builtin_shufflevector(lo, hi, 0, 1, 2, 3, 4, 5, 6, 7);
                    }
            }
#pragma unroll
            for (int dl = 0; dl < 4; ++dl) {
                const int dt = 4 * hf + dl;
#pragma unroll
                for (int ks = 0; ks < 2; ++ks) {
                    const s16x4 lo = lds_tr4(KI + (32 * ks + 8 * fq + (fr >> 2)) * 136 + 16 * dt + 4 * (fr & 3)), hi = lds_tr4(KI + (32 * ks + 8 * fq + 4 + (fr >> 2)) * 136 + 16 * dt + 4 * (fr & 3));
                    aK[dl][ks] = __builtin_shufflevector(lo, hi, 0, 1, 2, 3, 4, 5, 6, 7);
                }
                dc[dl] = *(const LAS f32x4*)(DC + 16 * dt + 4 * fq);
            }
            __builtin_amdgcn_sched_barrier(0);
            f32x4 o[4];
            if (lat) {
#pragma unroll
                for (int tt = 0; tt < 4; ++tt) o[tt] = (f32x4){0.f, 0.f, 0.f, 0.f};
#pragma unroll
                for (int kk = 0; kk < 2; ++kk) {
                    u32x4 w; w.x = cvt_pk_bf16(S[2 * kk][0], S[2 * kk][1]); w.y = cvt_pk_bf16(S[2 * kk][2], S[2 * kk][3]); w.z = cvt_pk_bf16(S[2 * kk + 1][0], S[2 * kk + 1][1]); w.w = cvt_pk_bf16(S[2 * kk + 1][2], S[2 * kk + 1][3]);
                    const bf16x8 sa = __builtin_bit_cast(bf16x8, w);
#pragma unroll
                    for (int tt = 0; tt < 4; ++tt) o[tt] = __builtin_amdgcn_mfma_f32_16x16x32_bf16(sa, bq[kk][tt], o[tt], 0, 0, 0);
                }
#pragma unroll
                for (int x = 0; x < 2; ++x)
#pragma unroll
                    for (int ks = 0; ks < 2; ++ks) {
                        if (hf == 0) o[x] = __builtin_amdgcn_mfma_f32_16x16x32_bf16(vf[ks], bA[x][ks], o[x], 0, 0, 0); else o[2 + x] = __builtin_amdgcn_mfma_f32_16x16x32_bf16(vf[ks], bA[x][ks], o[2 + x], 0, 0, 0);
                    }
                LAS f32x4* ox = (LAS f32x4*)OX + (wave * 2) * 64 + lane;
                if (hf == 0) { ox[0] = o[2]; ox[64] = o[3]; } else { ox[0] = o[0]; ox[64] = o[1]; }
            }
#pragma unroll
            for (int ks = 0; ks < 2; ++ks)
#pragma unroll
                for (int dl = 0; dl < 4; ++dl) S[dl] = __builtin_amdgcn_mfma_f32_16x16x32_bf16(aK[dl][ks], vf[ks], S[dl], 0, 0, 0);
#pragma unroll
            for (int dl = 0; dl < 4; ++dl) S[dl] = S[dl] * dc[dl];
            LDS_BARRIER();
            if (lat) {
                const LAS f32x4* ox = (const LAS f32x4*)OX + ((wave ^ 4) * 2) * 64 + lane;
#pragma unroll
                for (int x = 0; x < 2; ++x) {
                    const f32x4 mine = hf == 0 ? o[x] : o[2 + x];
                    const f32x4 v = mine + ox[64 * x];
                    const int tp = 16 * (2 * hf + x) + fr; const size_t gr = (size_t)(row0 + (dir ? 63 - tp : tp));
                    u32x2 w; w.x = cvt_pk_bf16(v[0], v[1]); w.y = cvt_pk_bf16(v[2], v[3]);
                    *(u32x2*)(OUT + gr * D + 16 * et + 4 * fq) = w;
                }
            }
        }
#undef GLA_LOAD
#undef GLA_STAGE
    }
    __syncthreads();
}

__device__ __forceinline__ void gla_post_phase(const bf16_t* OFB, const bf16_t* QKVG, const float* hng, bf16_t* OG, int G) {
    const int lane = threadIdx.x & 63, wave = threadIdx.x >> 6;
    float hgv[16];
#pragma unroll
    for (int i = 0; i < 4; ++i) { const f32x4 t = *(const f32x4*)(hng + 16 * lane + 4 * i); hgv[4 * i] = t[0]; hgv[4 * i + 1] = t[1]; hgv[4 * i + 2] = t[2]; hgv[4 * i + 3] = t[3]; }
    for (int row = blockIdx.x * 8 + wave; row < ML; row += G * 8) {
        const int c = 16 * lane;
        const u32x4 f0 = *(const u32x4*)(OFB + (size_t)row * D + c), f1 = *(const u32x4*)(OFB + (size_t)row * D + c + 8);
        const u32x4 b0 = *(const u32x4*)(OFB + (size_t)ML * D + (size_t)row * D + c), b1 = *(const u32x4*)(OFB + (size_t)ML * D + (size_t)row * D + c + 8);
        const u32x4 g0 = *(const u32x4*)(QKVG + (size_t)row * N1 + 2048 + c), g1 = *(const u32x4*)(QKVG + (size_t)row * N1 + 2048 + c + 8);
        float o[16], g[16];
#pragma unroll
        for (int i = 0; i < 4; ++i) {
            o[2 * i] = bflo(f0[i]) + bflo(b0[i]); o[2 * i + 1] = bfhi(f0[i]) + bfhi(b0[i]);
            o[8 + 2 * i] = bflo(f1[i]) + bflo(b1[i]); o[8 + 2 * i + 1] = bfhi(f1[i]) + bfhi(b1[i]);
            g[2 * i] = bflo(g0[i]); g[2 * i + 1] = bfhi(g0[i]); g[8 + 2 * i] = bflo(g1[i]); g[8 + 2 * i + 1] = bfhi(g1[i]);
        }
        float ss = 0.f;
#pragma unroll
        for (int i = 0; i < 16; ++i) ss += o[i] * o[i];
        ss += __shfl_xor(ss, 1); ss += __shfl_xor(ss, 2); ss += __shfl_xor(ss, 4); ss += __shfl_xor(ss, 8);
        const float rstd = rsqrtf(ss * (1.f / 256.f) + EPS);
        unsigned w[8];
#pragma unroll
        for (int i = 0; i < 8; ++i) {
            const float y0 = o[2 * i] * rstd * hgv[2 * i] * silu_f(g[2 * i]), y1 = o[2 * i + 1] * rstd * hgv[2 * i + 1] * silu_f(g[2 * i + 1]);
            w[i] = cvt_pk_bf16(y0, y1);
        }
        *(u32x4*)(OG + (size_t)row * D + c) = (u32x4){w[0], w[1], w[2], w[3]};
        *(u32x4*)(OG + (size_t)row * D + c + 8) = (u32x4){w[4], w[5], w[6], w[7]};
    }
}

__device__ __forceinline__ void final_norm_phase(const bf16_t* X2, float* out, const float* g, int G) {
    const int lane = threadIdx.x & 63, wave = threadIdx.x >> 6;
    for (int row = blockIdx.x * 8 + wave; row < ML; row += G * 8) {
        const bf16_t* xr = X2 + (size_t)row * D; float* orow = out + (size_t)row * D;
        float x[16]; float ss = 0.f;
#pragma unroll
        for (int j = 0; j < 2; ++j) {
            const u32x4 u = *(const u32x4*)(xr + 8 * lane + 512 * j);
#pragma unroll
            for (int i = 0; i < 4; ++i) { x[8 * j + 2 * i] = bflo(u[i]); x[8 * j + 2 * i + 1] = bfhi(u[i]); }
        }
#pragma unroll
        for (int i = 0; i < 16; ++i) ss += x[i] * x[i];
        const float rstd = rsqrtf(wave_sum(ss) * (1.f / D) + EPS);
#pragma unroll
        for (int j = 0; j < 2; ++j)
#pragma unroll
            for (int i = 0; i < 2; ++i) {
                const int c = 8 * lane + 512 * j + 4 * i;
                const f32x4 xv = (f32x4){x[8 * j + 4 * i], x[8 * j + 4 * i + 1], x[8 * j + 4 * i + 2], x[8 * j + 4 * i + 3]};
                *(f32x4*)(orow + c) = (xv * rstd) * *(const f32x4*)(g + c);
            }
    }
}

#define XB_TMO      128
#define XB_XCNT(j)  (256  + 64 * (j))
#define XB_XSUB(j)  (1280 + 64 * (j))
#define XB_XGEN(j)  (2304 + 64 * (j))
#define XB_TOP      3328
#define XB_TOPGEN   3392
#define XCD_BAR_WORDS 3456
#define XB_SPIN_CAP (1u << 18)
__device__ __forceinline__ unsigned xb_ld(unsigned* p)              { return __hip_atomic_load(p, __ATOMIC_RELAXED, __HIP_MEMORY_SCOPE_AGENT); }
__device__ __forceinline__ unsigned xb_add(unsigned* p, unsigned v) { return __hip_atomic_fetch_add(p, v, __ATOMIC_RELAXED, __HIP_MEMORY_SCOPE_AGENT); }
__device__ __forceinline__ unsigned xb_xcc_id() { return (unsigned)__builtin_amdgcn_s_getreg((3 << 11) | 20) & 0xFu; }
#define XB_SPIN(cond, bar) do { unsigned _sp = 0; while (cond) { __builtin_amdgcn_s_sleep(1); \
    if ((++_sp & 255u) == 0u) { if (xb_ld(&(bar)[XB_TMO])) break; if (_sp > XB_SPIN_CAP) { atomicAdd(&(bar)[XB_TMO], 1u); break; } } } } while (0)
struct XcdBarrier { unsigned* bar; unsigned x; volatile LAS unsigned* st; };
__device__ __forceinline__ XcdBarrier xcd_barrier_post(unsigned* bar, volatile LAS unsigned* st) {
    XcdBarrier b; b.bar = bar; b.x = xb_xcc_id(); b.st = st;
    if (threadIdx.x == 0) (void)xb_add(&bar[XB_XCNT(b.x)], 1u);
    return b;
}
__device__ __forceinline__ void xcd_barrier_complete(unsigned* bar, unsigned x, unsigned& nloc, unsigned& nx) {
    const unsigned G = gridDim.x * gridDim.y * gridDim.z;
    unsigned sum, cnt, mine, sp = 0u;
    for (;;) {
        sum = 0u; cnt = 0u; mine = 0u;
#pragma unroll
        for (unsigned j = 0; j < 16; ++j) { const unsigned c = xb_ld(&bar[XB_XCNT(j)]); sum += c; cnt += (c > 0u) ? 1u : 0u; mine = (j == x) ? c : mine; }
        if (sum == G) break;
        __builtin_amdgcn_s_sleep(1);
        if ((++sp & 255u) == 0u) { if (xb_ld(&bar[XB_TMO])) break; if (sp > XB_SPIN_CAP) { atomicAdd(&bar[XB_TMO], 1u); break; } }
    }
    nloc = mine > 0u ? mine : 1u; nx = cnt > 0u ? cnt : 1u;
}
__device__ __forceinline__ void xcd_barrier(const XcdBarrier& b) {
    asm volatile("s_waitcnt vmcnt(0)" ::: "memory");
    __syncthreads();
    if (threadIdx.x == 0) {
        unsigned* bar = b.bar;
        __builtin_amdgcn_s_waitcnt(0);
        unsigned nloc = b.st[0], nx = b.st[1];
        if (nloc == 0u) { xcd_barrier_complete(bar, b.x, nloc, nx); b.st[0] = nloc; b.st[1] = nx; }
        const unsigned old = xb_add(&bar[XB_XSUB(b.x)], 1u);
        const unsigned gen = old / nloc;
        if (old + 1u == (gen + 1u) * nloc) {
            __builtin_amdgcn_fence(__ATOMIC_RELEASE, "agent");
            asm volatile("s_waitcnt vmcnt(0)" ::: "memory");
            const unsigned og = xb_add(&bar[XB_TOP], 1u);
            const unsigned tg = og / nx;
            if (og + 1u == (tg + 1u) * nx) xb_add(&bar[XB_TOPGEN], 1u);
            else XB_SPIN(xb_ld(&bar[XB_TOPGEN]) == tg, bar);
            __builtin_amdgcn_fence(__ATOMIC_ACQUIRE, "agent");
            xb_add(&bar[XB_XGEN(b.x)], 1u);
            asm volatile("s_waitcnt vmcnt(0)" ::: "memory");
        } else {
            XB_SPIN(xb_ld(&bar[XB_XGEN(b.x)]) == gen, bar);
            __builtin_amdgcn_fence(__ATOMIC_ACQUIRE, "agent");
            asm volatile("s_waitcnt vmcnt(0)" ::: "memory");
        }
    }
    __syncthreads();
}

__global__ void __launch_bounds__(512, 2) fwd_megakernel(Args args) {
    extern __shared__ __attribute__((aligned(16))) unsigned char lds_raw[];
    LAS unsigned char* lds = (LAS unsigned char*)lds_raw;
    if (threadIdx.x < 2) ((LAS unsigned*)(lds + LDS_MISC_OFF))[threadIdx.x] = 0u;
    __syncthreads();
    const XcdBarrier xbar = xcd_barrier_post((unsigned*)(args.ws + WS_CTL), (volatile LAS unsigned*)(lds + LDS_MISC_OFF));
    const int G = gridDim.x;
    unsigned char* ws = args.ws;
    const int lo = args.ph_lo, hi = args.ph_hi;
#ifndef PH_MASK
#define PH_MASK 0xfff
#endif
#define IN(k) (((PH_MASK >> (k)) & 1) && lo <= (k) && (k) < hi)
#define SEAM(k) do { if (IN(k) && IN((k) + 1)) xcd_barrier(xbar); } while (0)
#ifndef DUP_MASK
#define DUP_MASK 0x000
#endif
#define REP(k) for (int rep_ = 0; rep_ <= ((DUP_MASK >> (k)) & 1); ++rep_) if (rep_ == 0 || (xcd_barrier(xbar), true))
    bf16_t* WT0 = (bf16_t*)(ws + WS_WT0); bf16_t* WO0 = (bf16_t*)(ws + WS_WO0); bf16_t* WT1 = (bf16_t*)(ws + WS_WT1); bf16_t* WO1 = (bf16_t*)(ws + WS_WO1);
    float* MOD0 = (float*)(ws + WS_MOD0); float* MOD1 = (float*)(ws + WS_MOD1);
    float* cosT = (float*)(ws + WS_ROPE); float* sinT = cosT + 1024;
    float* R = (float*)(ws + WS_R); bf16_t* X1 = (bf16_t*)(ws + WS_X1); float* DEC = (float*)(ws + WS_DEC);
    bf16_t* QKVG = (bf16_t*)(ws + WS_A); bf16_t* HB = (bf16_t*)(ws + WS_B);
    bf16_t* OUTB = (bf16_t*)args.out;

    if (IN(0)) REP(0) { p0_prologue(args, lds, (int)blockIdx.x, G, 0); }
    if (IN(1)) REP(1) { norm_mod_wait_phase(args.in[I_X], args.in[I_CTX], args.in[I_L0_NG], MOD0, HB, G); } SEAM(1);
    if (IN(2)) REP(2) {
        pg8::Gemm g{HB, WT0, MT, N0, D}; pg8::Sched S; S.init(MT, N0, G, (int)blockIdx.x, 0);
        pg8::EpiQKVG0 E{QKVG, cosT, sinT};
        pg8::gemm_phase<pg8::EpiQKVG0, pg8::Sched, true, true>(lds, g, S, E);
        { const int r = ((MT / 256) * (N0 / 256)) % G, first = r, nidle = G - r;
          if ((int)blockIdx.x >= first) { __syncthreads(); p0_prologue(args, lds, (int)blockIdx.x - first, nidle, 1); } }
    } SEAM(2);
    if (IN(3)) REP(3) { attn_phase(QKVG, args.in[I_L0_SINK], OUTB, lds, G); } SEAM(3);
    const bool fuse_pn = (G == 256) && lo == 0 && hi == NPHASE;
    if (IN(4)) REP(4) {
        pg8::Gemm g{OUTB, WO0, MT, D, D};
        if (fuse_pn) {
            pg8::SchedPanel S{G, (int)blockIdx.x};
            pg8::EpiRes0Norm E{args.in[I_X], args.in[I_CTX], MOD0, MOD1, args.in[I_L1_NG], X1, HB, (unsigned long long*)(ws + WS_SS4)};
            pg8::gemm_phase<pg8::EpiRes0Norm, pg8::SchedPanel, true, true>(lds, g, S, E);
        } else {
            pg8::Sched S; S.init(MT, D, G, (int)blockIdx.x, 0);
            pg8::EpiRes0 E{args.in[I_X], args.in[I_CTX], MOD0, X1};
            pg8::gemm_phase<pg8::EpiRes0, pg8::Sched, true, true>(lds, g, S, E);
        }
    } SEAM(4);
    if (!fuse_pn) { if (IN(5)) REP(5) { norm_mod_bf16_phase(X1, args.in[I_L1_NG], MOD1, HB, G); } SEAM(5); }
    if (IN(6)) REP(6) {
        pg8::Gemm g{HB, WT1, ML, N1P, D}; pg8::Sched S; S.init(ML, N1P, G, (int)blockIdx.x, 56);
        pg8::EpiQKVG1 E{QKVG, R};
        pg8::gemm_phase<pg8::EpiQKVG1, pg8::Sched, true, true>(lds, g, S, E);
    } SEAM(6);
    if (IN(7)) REP(7) { gla_prep_phase(args, QKVG, R, HB, HB + (size_t)ML * 512, DEC, lds, G); } SEAM(7);
    if (IN(8)) REP(8) { gla_phase(QKVG, HB, HB + (size_t)ML * 512, DEC, OUTB, lds, G); } SEAM(8);
    if (IN(9)) REP(9) { gla_post_phase(OUTB, QKVG, args.in[I_L1_HNG], HB, G); } SEAM(9);
    const bool fuse_fn = (G == 256) && lo == 0 && hi == NPHASE;
    if (IN(10)) REP(10) {
        pg8::Gemm g{HB, WO1, ML, D, D}; pg8::Sched S; S.init(ML, D, G, (int)blockIdx.x, 0);
        if (fuse_fn) {
            pg8::EpiResNorm E{X1, MOD1, args.in[I_FNG], args.out, (unsigned long long*)(ws + WS_SS)};
            pg8::gemm_phase<pg8::EpiResNorm, pg8::Sched, true, true>(lds, g, S, E);
        } else {
            pg8::EpiRes1 E{X1, MOD1, QKVG};
            pg8::gemm_phase<pg8::EpiRes1, pg8::Sched, true, true>(lds, g, S, E);
        }
    }
    if (!fuse_fn) { SEAM(10); if (IN(11)) REP(11) { final_norm_phase(QKVG, args.out, args.in[I_FNG], G); } }
#undef IN
#undef SEAM
}

extern "C" void kernel_launch(void* const* d_in, const int* in_sizes, int n_in, void* d_out, int out_size, void* d_ws, size_t ws_size, hipStream_t stream) {
    static int grid = 0;
    if (grid == 0) {
        int dev = 0, cus = 0, per_cu = 0;
        if (n_in != 23 || ws_size < WS_END) { fprintf(stderr, "kernel_launch: unexpected inputs (n_in %d, ws %zu)\n", n_in, ws_size); grid = -1; return; }
        (void)hipGetDevice(&dev);
        (void)hipDeviceGetAttribute(&cus, hipDeviceAttributeMultiprocessorCount, dev);
        if (hipFuncSetAttribute((const void*)fwd_megakernel, hipFuncAttributeMaxDynamicSharedMemorySize, LDS_BYTES) != hipSuccess) { fprintf(stderr, "kernel_launch: hipFuncSetAttribute failed\n"); grid = -1; return; }
        if (hipOccupancyMaxActiveBlocksPerMultiprocessor(&per_cu, (const void*)fwd_megakernel, 512, LDS_BYTES) != hipSuccess || per_cu < 1) { fprintf(stderr, "kernel_launch: occupancy query says %d blocks per CU\n", per_cu); per_cu = 1; }
        (void)hipGetLastError();
        grid = cus;
    }
    if (grid < 0) return;
    if (hipMemsetAsync((char*)d_ws + WS_CTL, 0, CTL_BYTES, stream) != hipSuccess) { fprintf(stderr, "kernel_launch: memset failed\n"); return; }
    Args a{};
    for (int i = 0; i < 23; ++i) a.in[i] = (const float*)d_in[i];
    a.out = (float*)d_out; a.ws = (unsigned char*)d_ws;
#if MK_N_LAUNCHES == 1
    a.ph_lo = 0; a.ph_hi = NPHASE;
    void* kargs[] = {&a};
    hipError_t e = hipLaunchCooperativeKernel((const void*)fwd_megakernel, dim3(grid), dim3(512), kargs, LDS_BYTES, stream);
    if (e != hipSuccess) fprintf(stderr, "cooperative launch failed: %s (grid %d)\n", hipGetErrorString(e), grid);
#else
    for (int p = 0; p < NPHASE; ++p) {
        a.ph_lo = p; a.ph_hi = p + 1;
        hipLaunchKernelGGL(fwd_megakernel, dim3(grid), dim3(512), LDS_BYTES, stream, a);
    }
#endif
}
```
